# Optimizing an MI355X kernel written in HIP

```python
import jax, jax.numpy as jnp
from jax import lax
import numpy as np

D_MODEL = 2048
BATCH = 4
SEQ = 4096
DEPTH = 2

CHUNK = 64
Q_BLOCK = 128
N_MIXERS = 2
N_MLA_LAYERS = (DEPTH + 1) // 2
N_FOX_LAYERS = DEPTH // 2

MLA_HEADS = 16
MLA_NOPE_DIM = 128
MLA_ROPE_DIM = 64
MLA_V_DIM = 128
MLA_Q_RANK = 512
MLA_KV_RANK = 512
MLA_IN_DIM = MLA_Q_RANK + MLA_KV_RANK + MLA_ROPE_DIM
ROPE_THETA = 10000.0

FOX_HEADS = 16
FOX_HEAD_DIM = 128
FOX_WIDTH = FOX_HEADS * FOX_HEAD_DIM
FOX_IN_DIM = 3 * FOX_WIDTH + FOX_HEADS

FFN_HIDDEN = -(-(8 * D_MODEL) // (3 * 256)) * 256

DEEPNORM_ALPHA = float((2 * DEPTH) ** 0.25)
DEEPNORM_BETA = float((8 * DEPTH) ** -0.25)
LN_EPS = 1e-5
RMS_EPS = 1e-6
NEG_INF = -1e30

kernel_name = "mla_fox_interleaved_deepnorm_trunk"


def layer_norm(x, g, b):
    xf = x.astype(jnp.float32)
    mu = jnp.mean(xf, axis=-1, keepdims=True)
    var = jnp.mean(jnp.square(xf - mu), axis=-1, keepdims=True)
    y = (xf - mu) * lax.rsqrt(var + LN_EPS)
    return (y * g.astype(jnp.float32) + b.astype(jnp.float32)).astype(x.dtype)


def rms_norm(x, g):
    xf = x.astype(jnp.float32)
    y = xf * lax.rsqrt(jnp.mean(jnp.square(xf), axis=-1, keepdims=True) + RMS_EPS)
    return (y * g.astype(jnp.float32)).astype(x.dtype)


def rope_tables(positions, dim):
    inv_freq = ROPE_THETA ** (-jnp.arange(0, dim, 2, dtype=jnp.float32) / dim)
    ang = positions.astype(jnp.float32)[..., None] * inv_freq
    return jnp.cos(ang), jnp.sin(ang)


def apply_rope(t, cos, sin):
    half = t.shape[-1] // 2
    t1 = t[..., :half].astype(jnp.float32)
    t2 = t[..., half:].astype(jnp.float32)
    out = jnp.concatenate([t1 * cos - t2 * sin, t2 * cos + t1 * sin], axis=-1)
    return out.astype(t.dtype)


def to_blocks(t):
    b, s = t.shape[0], t.shape[1]
    return jnp.moveaxis(t.reshape(b, s // Q_BLOCK, Q_BLOCK, *t.shape[2:]), 1, 0)


def from_blocks(t):
    n, b = t.shape[0], t.shape[1]
    return jnp.moveaxis(t, 0, 1).reshape(b, n * Q_BLOCK, *t.shape[3:])


def mla_mixer(x, cos, sin, w_in, q_norm_g, w_q_up, kv_norm_g, w_kv_up, w_o):
    b, s, _ = x.shape
    h = jnp.einsum('bsd,de->bse', x, w_in)
    c_q = h[..., :MLA_Q_RANK]
    c_kv = h[..., MLA_Q_RANK:MLA_Q_RANK + MLA_KV_RANK]
    k_rope = h[..., MLA_Q_RANK + MLA_KV_RANK:]
    q = jnp.einsum('bsr,re->bse', rms_norm(c_q, q_norm_g), w_q_up)
    q = q.reshape(b, s, MLA_HEADS, MLA_NOPE_DIM + MLA_ROPE_DIM)
    q_nope = q[..., :MLA_NOPE_DIM]
    q_rope = apply_rope(q[..., MLA_NOPE_DIM:], cos[:, :, None, :], sin[:, :, None, :])
    k_rope = apply_rope(k_rope, cos, sin)
    kv = jnp.einsum('bsr,re->bse', rms_norm(c_kv, kv_norm_g), w_kv_up)
    kv = kv.reshape(b, s, MLA_HEADS, MLA_NOPE_DIM + MLA_V_DIM)
    k_nope = kv[..., :MLA_NOPE_DIM]
    v = kv[..., MLA_NOPE_DIM:]
    scale = (MLA_NOPE_DIM + MLA_ROPE_DIM) ** -0.5
    k_chunk = jnp.arange(s) // CHUNK

    def block(args):
        i, qn, qr = args
        sc = (jnp.einsum('bqhn,bkhn->bhqk', qn, k_nope)
              + jnp.einsum('bqhr,bkr->bhqk', qr, k_rope)).astype(jnp.float32) * scale
        q_chunk = (i * Q_BLOCK + jnp.arange(Q_BLOCK)) // CHUNK
        allowed = k_chunk[None, :] <= q_chunk[:, None]
        sc = jnp.where(allowed, sc, NEG_INF)
        p = jax.nn.softmax(sc, axis=-1).astype(v.dtype)
        return jnp.einsum('bhqk,bkhv->bqhv', p, v)

    n_blk = s // Q_BLOCK
    o = lax.map(block, (jnp.arange(n_blk), to_blocks(q_nope), to_blocks(q_rope)))
    o = from_blocks(o).reshape(b, s, MLA_HEADS * MLA_V_DIM)
    return jnp.einsum('bse,ed->bsd', o, w_o)


def fox_mixer(x, w_in, b_f, w_o):
    b, s, _ = x.shape
    h = jnp.einsum('bsd,de->bse', x, w_in)
    q = h[..., :FOX_WIDTH].reshape(b, s, FOX_HEADS, FOX_HEAD_DIM)
    k = h[..., FOX_WIDTH:2 * FOX_WIDTH].reshape(b, s, FOX_HEADS, FOX_HEAD_DIM)
    v = h[..., 2 * FOX_WIDTH:3 * FOX_WIDTH].reshape(b, s, FOX_HEADS, FOX_HEAD_DIM)
    f_logit = h[..., 3 * FOX_WIDTH:].astype(jnp.float32) + b_f.astype(jnp.float32)
    log_f = jax.nn.log_sigmoid(f_logit)
    c = jnp.cumsum(log_f, axis=1)
    c_k = jnp.transpose(c, (0, 2, 1))
    scale = FOX_HEAD_DIM ** -0.5
    k_pos = jnp.arange(s)

    def block(args):
        i, qb, cb = args
        sc = jnp.einsum('bqhd,bkhd->bhqk', qb, k).astype(jnp.float32) * scale
        sc = sc + jnp.transpose(cb, (0, 2, 1))[..., None] - c_k[:, :, None, :]
        q_pos = i * Q_BLOCK + jnp.arange(Q_BLOCK)
        sc = jnp.where(k_pos[None, :] <= q_pos[:, None], sc, NEG_INF)
        p = jax.nn.softmax(sc, axis=-1).astype(v.dtype)
        return jnp.einsum('bhqk,bkhd->bqhd', p, v)

    n_blk = s // Q_BLOCK
    o = lax.map(block, (jnp.arange(n_blk), to_blocks(q), to_blocks(c)))
    o = from_blocks(o).reshape(b, s, FOX_WIDTH)
    return jnp.einsum('bse,ed->bsd', o, w_o)


def swiglu_ffn(x, w_gu, w_down):
    gu = jnp.einsum('bsd,df->bsf', x, w_gu)
    g, u = gu[..., :FFN_HIDDEN], gu[..., FFN_HIDDEN:]
    return jnp.einsum('bsf,fd->bsd', jax.nn.silu(g) * u, w_down)


def _dense(key, shape, fan_in, scale=1.0):
    return jax.random.normal(key, shape, jnp.float32) * (scale * fan_in ** -0.5)


def setup_inputs(seed: int = 0) -> dict:
    key = jax.random.key(seed)
    ks = jax.random.split(key, 24)
    NA, NF, L, D = N_MLA_LAYERS, N_FOX_LAYERS, DEPTH, D_MODEL
    beta = DEEPNORM_BETA
    x = jax.random.normal(ks[0], (BATCH, SEQ, D), jnp.float32)
    offset = jax.random.randint(ks[1], (BATCH, 1), 0, 1024, dtype=jnp.int32) * CHUNK
    positions = (offset + jnp.arange(SEQ, dtype=jnp.int32)[None, :]).astype(jnp.int32)

    mla_w_in = _dense(ks[2], (NA, D, MLA_IN_DIM), D)
    mla_q_norm_g = 1.0 + 0.02 * jax.random.normal(ks[3], (NA, MLA_Q_RANK), jnp.float32)
    mla_w_q_up = _dense(ks[4], (NA, MLA_Q_RANK, MLA_HEADS * (MLA_NOPE_DIM + MLA_ROPE_DIM)), MLA_Q_RANK)
    mla_kv_norm_g = 1.0 + 0.02 * jax.random.normal(ks[5], (NA, MLA_KV_RANK), jnp.float32)
    wk = _dense(ks[6], (NA, MLA_KV_RANK, MLA_HEADS, MLA_NOPE_DIM), MLA_KV_RANK)
    wv = _dense(ks[7], (NA, MLA_KV_RANK, MLA_HEADS, MLA_V_DIM), MLA_KV_RANK, beta)
    mla_w_kv_up = jnp.concatenate([wk, wv], axis=-1).reshape(
        NA, MLA_KV_RANK, MLA_HEADS * (MLA_NOPE_DIM + MLA_V_DIM))
    mla_w_o = _dense(ks[8], (NA, MLA_HEADS * MLA_V_DIM, D), MLA_HEADS * MLA_V_DIM, beta)

    fq = _dense(ks[9], (NF, D, FOX_WIDTH), D)
    fk = _dense(ks[10], (NF, D, FOX_WIDTH), D)
    fv = _dense(ks[11], (NF, D, FOX_WIDTH), D, beta)
    ff = _dense(ks[12], (NF, D, FOX_HEADS), D, 0.1)
    fox_w_in = jnp.concatenate([fq, fk, fv, ff], axis=-1)
    fox_b_f = 4.0 + 0.5 * jax.random.normal(ks[13], (NF, FOX_HEADS), jnp.float32)
    fox_w_o = _dense(ks[14], (NF, FOX_WIDTH, D), FOX_WIDTH, beta)

    ffn_w_gu = _dense(ks[15], (L, D, 2 * FFN_HIDDEN), D, beta)
    ffn_w_down = _dense(ks[16], (L, FFN_HIDDEN, D), FFN_HIDDEN, beta)
    ln_mix_g = 1.0 + 0.02 * jax.random.normal(ks[17], (L, D), jnp.float32)
    ln_mix_b = 0.02 * jax.random.normal(ks[18], (L, D), jnp.float32)
    ln_ffn_g = 1.0 + 0.02 * jax.random.normal(ks[19], (L, D), jnp.float32)
    ln_ffn_b = 0.02 * jax.random.normal(ks[20], (L, D), jnp.float32)
    return {
        "x": x, "positions": positions,
        "mla_w_in": mla_w_in, "mla_q_norm_g": mla_q_norm_g, "mla_w_q_up": mla_w_q_up,
        "mla_kv_norm_g": mla_kv_norm_g, "mla_w_kv_up": mla_w_kv_up, "mla_w_o": mla_w_o,
        "fox_w_in": fox_w_in, "fox_b_f": fox_b_f, "fox_w_o": fox_w_o,
        "ffn_w_gu": ffn_w_gu, "ffn_w_down": ffn_w_down,
        "ln_mix_g": ln_mix_g, "ln_mix_b": ln_mix_b, "ln_ffn_g": ln_ffn_g, "ln_ffn_b": ln_ffn_b,
    }


def reference(x, positions, mla_w_in, mla_q_norm_g, mla_w_q_up, mla_kv_norm_g, mla_w_kv_up,
              mla_w_o, fox_w_in, fox_b_f, fox_w_o, ffn_w_gu, ffn_w_down,
              ln_mix_g, ln_mix_b, ln_ffn_g, ln_ffn_b):
    cos, sin = rope_tables(positions, MLA_ROPE_DIM)
    for i in range(DEPTH):
        j = i // N_MIXERS
        if i % N_MIXERS == 0:
            mix = mla_mixer(x, cos, sin, mla_w_in[j], mla_q_norm_g[j], mla_w_q_up[j],
                            mla_kv_norm_g[j], mla_w_kv_up[j], mla_w_o[j])
        else:
            mix = fox_mixer(x, fox_w_in[j], fox_b_f[j], fox_w_o[j])
        x = layer_norm(DEEPNORM_ALPHA * x + mix, ln_mix_g[i], ln_mix_b[i])
        x = layer_norm(DEEPNORM_ALPHA * x + swiglu_ffn(x, ffn_w_gu[i], ffn_w_down[i]),
                       ln_ffn_g[i], ln_ffn_b[i])
    return x
```

```cpp
#include <hip/hip_runtime.h>
#include <hip/hip_cooperative_groups.h>
#include <hip/hip_bf16.h>
#include <cstdio>
#include <cstdint>
namespace cg = cooperative_groups;
#ifndef ONE_LAUNCH
#define ONE_LAUNCH 1
#endif
__device__ __forceinline__ int lane_opaque() { int l; asm volatile("v_mbcnt_lo_u32_b32 %0, -1, 0\n\tv_mbcnt_hi_u32_b32 %0, -1, %0" : "=v"(l)); return l; }
#define LAS __attribute__((address_space(3)))
#define XB_TMO      128
#define XB_XCNT(j)  (256  + 64 * (j))
#define XB_XSUB(j)  (1280 + 64 * (j))
#define XB_XGEN(j)  (2304 + 64 * (j))
#define XB_TOP      3328
#define XB_TOPGEN   3392
#define XCD_BAR_WORDS 3456
#define XB_SPIN_CAP (1u << 18)

__device__ __forceinline__ unsigned xb_ld(unsigned* p)              { return __hip_atomic_load(p, __ATOMIC_RELAXED, __HIP_MEMORY_SCOPE_AGENT); }
__device__ __forceinline__ unsigned xb_add(unsigned* p, unsigned v) { return __hip_atomic_fetch_add(p, v, __ATOMIC_RELAXED, __HIP_MEMORY_SCOPE_AGENT); }
__device__ __forceinline__ unsigned xb_xcc_id() { return (unsigned)__builtin_amdgcn_s_getreg((3 << 11) | 20) & 0xFu; }
#define XB_SPIN(cond, bar) do { unsigned _sp = 0; while (cond) { __builtin_amdgcn_s_sleep(1); \
    if ((++_sp & 255u) == 0u) { if (xb_ld(&(bar)[XB_TMO])) break; if (_sp > XB_SPIN_CAP) { atomicAdd(&(bar)[XB_TMO], 1u); break; } } } } while (0)

struct XcdBarrier {
    unsigned* bar; unsigned x;
    volatile LAS unsigned* st;
};

__device__ __forceinline__ XcdBarrier xcd_barrier_post(unsigned* bar, volatile LAS unsigned* st, const bool t0) {
    XcdBarrier b; b.bar = bar; b.x = xb_xcc_id(); b.st = st;
    if (t0) (void)xb_add(&bar[XB_XCNT(b.x)], 1u);
    return b;
}
__device__ __forceinline__ void xcd_barrier_complete(unsigned* bar, unsigned x, unsigned& nloc, unsigned& nx) {
    const unsigned G = gridDim.x * gridDim.y * gridDim.z;
    unsigned sum, cnt, mine, sp = 0u;
    for (;;) {
        sum = 0u; cnt = 0u; mine = 0u;
#pragma unroll
        for (unsigned j = 0; j < 16; ++j) { const unsigned c = xb_ld(&bar[XB_XCNT(j)]); sum += c; cnt += (c > 0u) ? 1u : 0u; mine = (j == x) ? c : mine; }
        if (sum == G) break;
        __builtin_amdgcn_s_sleep(1);
        if ((++sp & 255u) == 0u) { if (xb_ld(&bar[XB_TMO])) break; if (sp > XB_SPIN_CAP) { atomicAdd(&bar[XB_TMO], 1u); break; } }
    }
    nloc = mine > 0u ? mine : 1u; nx = cnt > 0u ? cnt : 1u;
}

__device__ __forceinline__ void xcd_barrier(const XcdBarrier& b, const bool t0) {
    asm volatile("s_waitcnt vmcnt(0)" ::: "memory");
    __syncthreads();
    if (t0) {
        unsigned* bar = b.bar;
        __builtin_amdgcn_s_waitcnt(0);
        unsigned nloc = b.st[0], nx = b.st[1];
        if (nloc == 0u) { xcd_barrier_complete(bar, b.x, nloc, nx); b.st[0] = nloc; b.st[1] = nx; }
        const unsigned old = xb_add(&bar[XB_XSUB(b.x)], 1u);
        const unsigned gen = old / nloc;
        if (old + 1u == (gen + 1u) * nloc) {
            __builtin_amdgcn_fence(__ATOMIC_RELEASE, "agent");
            asm volatile("s_waitcnt vmcnt(0)" ::: "memory");
            const unsigned og = xb_add(&bar[XB_TOP], 1u);
            const unsigned tg = og / nx;
            if (og + 1u == (tg + 1u) * nx) xb_add(&bar[XB_TOPGEN], 1u);
            else XB_SPIN(xb_ld(&bar[XB_TOPGEN]) == tg, bar);
            __builtin_amdgcn_fence(__ATOMIC_ACQUIRE, "agent");
            xb_add(&bar[XB_XGEN(b.x)], 1u);
            asm volatile("s_waitcnt vmcnt(0)" ::: "memory");
        } else {
            XB_SPIN(xb_ld(&bar[XB_XGEN(b.x)]) == gen, bar);
            __builtin_amdgcn_fence(__ATOMIC_ACQUIRE, "agent");
            asm volatile("s_waitcnt vmcnt(0)" ::: "memory");
        }
    }
    __syncthreads();
}
namespace pg8 {
#define PG8_LAS __attribute__((address_space(3)))
typedef unsigned short bf16_t;
typedef short bf16x8 __attribute__((ext_vector_type(8)));
typedef float f32x4 __attribute__((ext_vector_type(4)));
typedef unsigned u32x4 __attribute__((ext_vector_type(4)));
constexpr int BM = 256, BK = 64, HALF = 128, HTB = HALF * BK * 2  , STAGE_BYTES = 8 * HTB, NXCD = 8, WGM = 8;

__host__ __device__ __forceinline__ int lds_byte(int r, int c) { const int st = (r >> 4) * 2 + (c >> 5), rr = r & 15, cc = c & 31, ob = rr * 64 + cc * 2; return st * 1024 + (ob ^ (((ob >> 9) & 1) << 5)); }
__host__ __device__ __forceinline__ void stage_rc(int b, int& R, int& C) { const int st = b / 1024, sb = b % 1024, swz = sb ^ (((sb >> 9) & 1) << 5); R = (st >> 1) * 16 + swz / 64; C = (st & 1) * 32 + (swz % 64) / 2; }
__host__ __device__ __forceinline__ int perm32(int rho) { const int n = rho >> 4, i = rho & 15; return 8 * (i >> 2) + 4 * n + (i & 3); }

struct Unit { int pm, pn; };
struct Gemm { const bf16_t* A; const bf16_t* Bt; int M, N, K; };

struct StaticOrder {
    int nM, nN, nwg, G, c;
    __host__ __device__ void init(int M, int N, int G_, int c_) { nM = M / BM; nN = N / BM; nwg = nM * nN; G = G_; c = c_; }
    __host__ __device__ bool next(int i, Unit& u) const {
        const long L = (long)i * G + c; if (L >= nwg) return false;
        int wgid = (int)L; { const int q = nwg / NXCD, r = nwg % NXCD, xcd = wgid % NXCD, off = wgid / NXCD; wgid = (xcd < r ? xcd * (q + 1) : r * (q + 1) + (xcd - r) * q) + off; }
        const int nig = WGM * nN, gid = wgid / nig, fm = gid * WGM, gsz = (nM - fm) < WGM ? (nM - fm) : WGM;
        u.pm = fm + ((wgid % nig) % gsz); u.pn = (wgid % nig) / gsz; return true;
    }
    __device__ __forceinline__ void a_ready(const Unit&) const {}
    __device__ __forceinline__ void done(const Unit&) const {}
};

__device__ __forceinline__ unsigned cvt_pk_bf16(float lo, float hi) { unsigned r; asm volatile("v_cvt_pk_bf16_f32 %0, %1, %2" : "=v"(r) : "v"(lo), "v"(hi)); return r; }
typedef float f32x2 __attribute__((ext_vector_type(2)));
typedef unsigned u32x2 __attribute__((ext_vector_type(2)));
struct EpiF32 {
    static constexpr bool PERM = false, AFTER_DRAIN = false;
    float* O; int ldc;
    __device__ __forceinline__ void operator()(const f32x4 (&acc)[2][2][4][2], const Unit& u, int wr, int wc, int fr, int fq) const {
        const int row0 = u.pm * BM + wr * 64 + fr, col0 = u.pn * BM + wc * 32 + 4 * fq;
#pragma unroll
        for (int ai = 0; ai < 2; ++ai)
#pragma unroll
            for (int m = 0; m < 4; ++m) { float* rowp = O + (size_t)(row0 + ai * HALF + m * 16) * ldc + col0;
#pragma unroll
                for (int bj = 0; bj < 2; ++bj)
#pragma unroll
                    for (int n = 0; n < 2; ++n) *(f32x4*)(rowp + bj * HALF + n * 16) = acc[ai][bj][m][n]; }
    }
};
struct EpiResid {
    static constexpr bool PERM = false, AFTER_DRAIN = false;
    const float* base; float* out; int ldc; float alpha;
    __device__ __forceinline__ void operator()(const f32x4 (&acc)[2][2][4][2], const Unit& u, int wr, int wc, int fr, int fq) const {
        const int row0 = u.pm * BM + wr * 64 + fr, col0 = u.pn * BM + wc * 32 + 4 * fq;
#pragma unroll
        for (int ai = 0; ai < 2; ++ai)
#pragma unroll
            for (int m = 0; m < 4; ++m) { const size_t off = (size_t)(row0 + ai * HALF + m * 16) * ldc + col0;
                f32x4 b[2][2];
#pragma unroll
                for (int bj = 0; bj < 2; ++bj)
#pragma unroll
                    for (int n = 0; n < 2; ++n) b[bj][n] = *(const f32x4*)(base + off + bj * HALF + n * 16);
#pragma unroll
                for (int bj = 0; bj < 2; ++bj)
#pragma unroll
                    for (int n = 0; n < 2; ++n) *(f32x4*)(out + off + bj * HALF + n * 16) = b[bj][n] * alpha + acc[ai][bj][m][n]; }
    }
};
__device__ __forceinline__ float silu_mul(float g, float u) { return g * __builtin_amdgcn_rcpf(1.0f + __builtin_amdgcn_exp2f(-1.4426950408889634f * g)) * u; }
struct EpiSwiglu {
    static constexpr bool PERM = true, AFTER_DRAIN = false;
    bf16_t* O; int ldc;
    __device__ __forceinline__ void operator()(const f32x4 (&acc)[2][2][4][2], const Unit& u, int wr, int wc, int fr, int fq) const {
        const int row0 = u.pm * BM + wr * 64 + fr, col0 = u.pn * HALF + wc * 32 + 8 * fq;
#pragma unroll
        for (int ai = 0; ai < 2; ++ai)
#pragma unroll
            for (int m = 0; m < 4; ++m) { bf16_t* rowp = O + (size_t)(row0 + ai * HALF + m * 16) * ldc + col0;
                const f32x4 g0 = acc[ai][0][m][0], g1 = acc[ai][0][m][1], u0 = acc[ai][1][m][0], u1 = acc[ai][1][m][1];
                u32x4 w; w.x = cvt_pk_bf16(silu_mul(g0[0], u0[0]), silu_mul(g0[1], u0[1])); w.y = cvt_pk_bf16(silu_mul(g0[2], u0[2]), silu_mul(g0[3], u0[3]));
                w.z = cvt_pk_bf16(silu_mul(g1[0], u1[0]), silu_mul(g1[1], u1[1])); w.w = cvt_pk_bf16(silu_mul(g1[2], u1[2]), silu_mul(g1[3], u1[3]));
#ifdef XNT
                __builtin_nontemporal_store(w, (u32x4*)rowp); }
#else
                *(u32x4*)rowp = w; }
#endif
    }
};
__device__ __forceinline__ u32x4 pack8bf(const f32x4 v0, const f32x4 v1) { u32x4 w; w.x = cvt_pk_bf16(v0[0], v0[1]); w.y = cvt_pk_bf16(v0[2], v0[3]); w.z = cvt_pk_bf16(v1[0], v1[1]); w.w = cvt_pk_bf16(v1[2], v1[3]); return w; }
struct EpiKV {
    static constexpr bool PERM = true, AFTER_DRAIN = false;
    bf16_t* Kb; bf16_t* Vb;
    __device__ __forceinline__ void operator()(const f32x4 (&acc)[2][2][4][2], const Unit& u, int wr, int wc, int fr, int fq) const {
        const int row0 = u.pm * BM + wr * 64 + fr, col0 = u.pn * HALF + wc * 32 + 8 * fq;
#pragma unroll
        for (int ai = 0; ai < 2; ++ai)
#pragma unroll
            for (int m = 0; m < 4; ++m) { const size_t off = (size_t)(row0 + ai * HALF + m * 16) * 2048 + col0;
                *(u32x4*)(Kb + off) = pack8bf(acc[ai][0][m][0], acc[ai][0][m][1]);
                *(u32x4*)(Vb + off) = pack8bf(acc[ai][1][m][0], acc[ai][1][m][1]); }
    }
};
struct EpiQrope {
    static constexpr bool PERM = true, AFTER_DRAIN = false;
    bf16_t* O; const float* tab;
    __device__ __forceinline__ void operator()(const f32x4 (&acc)[2][2][4][2], const Unit& u, int wr, int wc, int fr, int fq) const {
        const int row0 = u.pm * BM + wr * 64 + fr;
#pragma unroll
        for (int bj = 0; bj < 2; ++bj) {
            const int col0 = u.pn * BM + bj * HALF + wc * 32 + 8 * fq; const int w = col0 % 192; const bool rope = w >= 128; const int j0 = (w - 128) >> 1;
#pragma unroll
            for (int ai = 0; ai < 2; ++ai)
#pragma unroll
                for (int m = 0; m < 4; ++m) { const int row = row0 + ai * HALF + m * 16;
                    f32x4 v0 = acc[ai][bj][m][0], v1 = acc[ai][bj][m][1];
                    if (rope) { const f32x4 cs0 = *(const f32x4*)(tab + ((size_t)row * 32 + j0) * 2), cs1 = *(const f32x4*)(tab + ((size_t)row * 32 + j0 + 2) * 2);
                        f32x4 r0, r1;
                        r0[0] = v0[0] * cs0[0] - v0[1] * cs0[1]; r0[1] = v0[1] * cs0[0] + v0[0] * cs0[1];
                        r0[2] = v0[2] * cs0[2] - v0[3] * cs0[3]; r0[3] = v0[3] * cs0[2] + v0[2] * cs0[3];
                        r1[0] = v1[0] * cs1[0] - v1[1] * cs1[1]; r1[1] = v1[1] * cs1[0] + v1[0] * cs1[1];
                        r1[2] = v1[2] * cs1[2] - v1[3] * cs1[3]; r1[3] = v1[3] * cs1[2] + v1[2] * cs1[3];
                        v0 = r0; v1 = r1; }
                    *(u32x4*)(O + (size_t)row * 3072 + col0) = pack8bf(v0, v1); }
        }
    }
};
__device__ __forceinline__ float lsig(float x) { return fminf(x, 0.f) - 0.6931471805599453f * __builtin_amdgcn_logf(1.0f + __builtin_amdgcn_exp2f(-1.4426950408889634f * fabsf(x))); }
struct EpiFoxIn {
    static constexpr bool PERM = true, AFTER_DRAIN = false;
    bf16_t* QKV; size_t stride; float* logf; const float* bf;
    __device__ __forceinline__ void operator()(const f32x4 (&acc)[2][2][4][2], const Unit& u, int wr, int wc, int fr, int fq) const {
        const int row0 = u.pm * BM + wr * 64 + fr;
        if (u.pn < 24) {
            bf16_t* base = QKV + (size_t)(u.pn >> 3) * stride; const int colt = (u.pn & 7) * BM + wc * 32 + 8 * fq;
#pragma unroll
            for (int ai = 0; ai < 2; ++ai)
#pragma unroll
                for (int m = 0; m < 4; ++m) { bf16_t* rowp = base + (size_t)(row0 + ai * HALF + m * 16) * 2048 + colt;
#pragma unroll
                    for (int bj = 0; bj < 2; ++bj) *(u32x4*)(rowp + bj * HALF) = pack8bf(acc[ai][bj][m][0], acc[ai][bj][m][1]); }
        } else if (wc == 0 && fq < 2) {
#pragma unroll
            for (int ai = 0; ai < 2; ++ai)
#pragma unroll
                for (int m = 0; m < 4; ++m) { const int row = row0 + ai * HALF + m * 16;
#pragma unroll
                    for (int n = 0; n < 2; ++n) { const int c = 8 * fq + 4 * n; const f32x4 bb = *(const f32x4*)(bf + c); const f32x4 x = acc[ai][0][m][n] + bb; f32x4 o;
                        o[0] = lsig(x[0]); o[1] = lsig(x[1]); o[2] = lsig(x[2]); o[3] = lsig(x[3]);
                        *(f32x4*)(logf + (size_t)row * 16 + c) = o; } }
        }
    }
};

struct EpiResidLN {
    static constexpr bool PERM = false, AFTER_DRAIN = true;
    const float* base; float* out; bf16_t* xb; const float* g; const float* bt; float* part  ; XcdBarrier bar; float alpha; float accs;
    __device__ __forceinline__ void fused(f32x4 (&acc)[2][2][4][2], const Unit& u, int wr, int wc, int fr, int fq, PG8_LAS unsigned char* lds, int wid, int lane) const {
        PG8_LAS f32x2* P = (PG8_LAS f32x2*)lds;
        PG8_LAS f32x2* S = (PG8_LAS f32x2*)(lds + 8192);
        const int col0 = u.pn * BM + wc * 32 + 4 * fq;
#pragma unroll
        for (int ai = 0; ai < 2; ++ai)
#pragma unroll
            for (int m = 0; m < 4; ++m) { const size_t off = (size_t)(u.pm * BM + ai * HALF + wr * 64 + m * 16 + fr) * 2048 + col0;
                float s = 0.f, q = 0.f;
#pragma unroll
                for (int bj = 0; bj < 2; ++bj)
#pragma unroll
                    for (int n = 0; n < 2; ++n) { const f32x4 b = *(const f32x4*)(base + off + bj * HALF + n * 16); const f32x4 v = b * alpha + acc[ai][bj][m][n] * accs; acc[ai][bj][m][n] = v;
                        s += (v[0] + v[1]) + (v[2] + v[3]); q += (v[0] * v[0] + v[1] * v[1]) + (v[2] * v[2] + v[3] * v[3]); }
                s += __shfl_xor(s, 16); s += __shfl_xor(s, 32); q += __shfl_xor(q, 16); q += __shfl_xor(q, 32);
                if (fq == 0) P[(ai * HALF + wr * 64 + m * 16 + fr) * 4 + wc] = (f32x2){s, q};
                if (m & 1) asm volatile("" ::: "memory"); }
        asm volatile("s_waitcnt lgkmcnt(0)" ::: "memory"); __builtin_amdgcn_s_barrier(); asm volatile("" ::: "memory");
        const int tid = wid * 64 + lane;
        if (tid < 256) { const f32x2 a = P[tid * 4 + 0], b = P[tid * 4 + 1], c = P[tid * 4 + 2], d = P[tid * 4 + 3];
            const float s = (a.x + b.x) + (c.x + d.x), q = (a.y + b.y) + (c.y + d.y);
            unsigned long long* slot = (unsigned long long*)part + ((size_t)(u.pm * BM + tid) * 8 + u.pn);
            __hip_atomic_store(slot, ((unsigned long long)__float_as_uint(q) << 32) | __float_as_uint(s), __ATOMIC_RELAXED, __HIP_MEMORY_SCOPE_AGENT); }
        xcd_barrier(bar, tid == 0);
        if (tid < 256) { const unsigned long long* slot = (const unsigned long long*)part + (size_t)(u.pm * BM + tid) * 8; float s = 0.f, q = 0.f;
#pragma unroll
            for (int t = 0; t < 8; ++t) { const unsigned long long w = __hip_atomic_load(slot + t, __ATOMIC_RELAXED, __HIP_MEMORY_SCOPE_AGENT); s += __uint_as_float((unsigned)w); q += __uint_as_float((unsigned)(w >> 32)); }
            const float mean = s * (1.f / 2048.f), var = fmaxf(q * (1.f / 2048.f) - mean * mean, 0.f);
            S[tid] = (f32x2){mean, 1.0f / sqrtf(var + 1e-5f)}; }
        asm volatile("s_waitcnt lgkmcnt(0)" ::: "memory"); __builtin_amdgcn_s_barrier(); asm volatile("" ::: "memory");
        f32x4 gg[2][2], bb[2][2];
#pragma unroll
        for (int bj = 0; bj < 2; ++bj)
#pragma unroll
            for (int n = 0; n < 2; ++n) { gg[bj][n] = *(const f32x4*)(g + col0 + bj * HALF + n * 16); bb[bj][n] = *(const f32x4*)(bt + col0 + bj * HALF + n * 16); }
#pragma unroll
        for (int ai = 0; ai < 2; ++ai)
#pragma unroll
            for (int m = 0; m < 4; ++m) { const int r = ai * HALF + wr * 64 + m * 16 + fr; const f32x2 sr = S[r]; const size_t off = (size_t)(u.pm * BM + r) * 2048 + col0;
#pragma unroll
                for (int bj = 0; bj < 2; ++bj)
#pragma unroll
                    for (int n = 0; n < 2; ++n) { const f32x4 o = (acc[ai][bj][m][n] - sr.x) * sr.y * gg[bj][n] + bb[bj][n];
                        *(f32x4*)(out + off + bj * HALF + n * 16) = o; if (xb) { u32x2 w; w.x = cvt_pk_bf16(o[0], o[1]); w.y = cvt_pk_bf16(o[2], o[3]); *(u32x2*)(xb + off + bj * HALF + n * 16) = w; } } }
    }
};
struct PanelRound {
    int r, c;
    __device__ bool next(int i, Unit& u) const { if (i != 0) return false; const int x = c & 7, j = c >> 3; u.pm = r * 32 + x * 4 + (j & 3); u.pn = j >> 2; return true; }
    __device__ __forceinline__ void a_ready(const Unit&) const {}
    __device__ __forceinline__ void done(const Unit&) const {}
};

struct EpiRms {
    static constexpr bool PERM = true, AFTER_DRAIN = true;
    bf16_t* cqn; bf16_t* ckvn; const float* gq; const float* gkv; float* part  ; XcdBarrier bar;
    __device__ __forceinline__ void fused(f32x4 (&acc)[2][2][4][2], const Unit& u, int wr, int wc, int fr, int fq, PG8_LAS unsigned char* lds, int wid, int lane) const {
        PG8_LAS float* P = (PG8_LAS float*)lds;
        PG8_LAS float* S = (PG8_LAS float*)(lds + 4096);
#pragma unroll
        for (int ai = 0; ai < 2; ++ai)
#pragma unroll
            for (int m = 0; m < 4; ++m) { float q = 0.f;
#pragma unroll
                for (int bj = 0; bj < 2; ++bj)
#pragma unroll
                    for (int n = 0; n < 2; ++n) { const f32x4 v = acc[ai][bj][m][n]; q += (v[0] * v[0] + v[1] * v[1]) + (v[2] * v[2] + v[3] * v[3]); }
                q += __shfl_xor(q, 16); q += __shfl_xor(q, 32);
                if (fq == 0) P[(ai * HALF + wr * 64 + m * 16 + fr) * 4 + wc] = q; }
        asm volatile("s_waitcnt lgkmcnt(0)" ::: "memory"); __builtin_amdgcn_s_barrier(); asm volatile("" ::: "memory");
        const int tid = wid * 64 + lane;
        if (tid < 256) { const float q = (P[tid * 4 + 0] + P[tid * 4 + 1]) + (P[tid * 4 + 2] + P[tid * 4 + 3]);
            unsigned long long* slot = (unsigned long long*)part + ((size_t)(u.pm * BM + tid) * 8 + u.pn);
            __hip_atomic_store(slot, (unsigned long long)__float_as_uint(q), __ATOMIC_RELAXED, __HIP_MEMORY_SCOPE_AGENT); }
        xcd_barrier(bar, tid == 0);
        if (tid < 256) { const unsigned long long* slot = (const unsigned long long*)part + (size_t)(u.pm * BM + tid) * 8 + (u.pn & 2);
            const float q = __uint_as_float((unsigned)__hip_atomic_load(slot, __ATOMIC_RELAXED, __HIP_MEMORY_SCOPE_AGENT)) + __uint_as_float((unsigned)__hip_atomic_load(slot + 1, __ATOMIC_RELAXED, __HIP_MEMORY_SCOPE_AGENT));
            S[tid] = 1.0f / sqrtf(q * (1.f / 512.f) + 1e-6f); }
        asm volatile("s_waitcnt lgkmcnt(0)" ::: "memory"); __builtin_amdgcn_s_barrier(); asm volatile("" ::: "memory");
        bf16_t* O = (u.pn & 2) ? ckvn : cqn; const float* g = (u.pn & 2) ? gkv : gq;
        const int colp = (u.pn & 1) * BM + wc * 32 + 8 * fq;
        f32x4 gg[2][2];
#pragma unroll
        for (int bj = 0; bj < 2; ++bj)
#pragma unroll
            for (int n = 0; n < 2; ++n) gg[bj][n] = *(const f32x4*)(g + colp + bj * HALF + 4 * n);
#pragma unroll
        for (int ai = 0; ai < 2; ++ai)
#pragma unroll
            for (int m = 0; m < 4; ++m) { const int r = ai * HALF + wr * 64 + m * 16 + fr; const float rs = S[r]; bf16_t* rowp = O + (size_t)(u.pm * BM + r) * 512 + colp;
#pragma unroll
                for (int bj = 0; bj < 2; ++bj) *(u32x4*)(rowp + bj * HALF) = pack8bf(acc[ai][bj][m][0] * rs * gg[bj][0], acc[ai][bj][m][1] * rs * gg[bj][1]); }
    }
};
struct QuadOrder {
    int c;
    __device__ bool next(int i, Unit& u) const { if (i != 0) return false; const int x = c & 7, j = c >> 3; u.pm = x * 8 + (j & 7); u.pn = j >> 3; return true; }
    __device__ __forceinline__ void a_ready(const Unit&) const {}
    __device__ __forceinline__ void done(const Unit&) const {}
};
template <int NT>
__device__ __forceinline__ void skinny_gemm(const bf16_t* __restrict__ X, const bf16_t* __restrict__ Wt, int wrow0, int wstride, int rg, int lane, int k_lo, int k_hi, f32x4 (&acc)[NT]) {
    const int fr = lane & 15, fq = lane >> 4;
    const bf16_t* xa = X + (size_t)(rg * 16 + fr) * 2048 + 8 * fq;
    const bf16_t* wb = Wt + (size_t)(wrow0 + fr) * 2048 + 8 * fq;
#pragma unroll
    for (int nt = 0; nt < NT; ++nt) acc[nt] = (f32x4){0.f, 0.f, 0.f, 0.f};
    bf16x8 a0[4], b0[NT][4], a1[4], b1[NT][4];
#define SK_LOAD(A_, B_, k_) do { _Pragma("unroll") for (int u_ = 0; u_ < 4; ++u_) { A_[u_] = *(const bf16x8*)(xa + (k_) + 32 * u_); \
        _Pragma("unroll") for (int nt = 0; nt < NT; ++nt) B_[nt][u_] = *(const bf16x8*)(wb + (size_t)nt * wstride * 2048 + (k_) + 32 * u_); } } while (0)
#define SK_MMA(A_, B_) do { _Pragma("unroll") for (int u_ = 0; u_ < 4; ++u_) _Pragma("unroll") for (int nt = 0; nt < NT; ++nt) \
        acc[nt] = __builtin_amdgcn_mfma_f32_16x16x32_bf16(B_[nt][u_], A_[u_], acc[nt], 0, 0, 0); } while (0)
    SK_LOAD(a0, b0, k_lo);
    for (int k = k_lo; k < k_hi; k += 256) {
        SK_LOAD(a1, b1, k + 128);
        SK_MMA(a0, b0);
        if (k + 256 < k_hi) SK_LOAD(a0, b0, k + 256);
        SK_MMA(a1, b1);
    }
#undef SK_LOAD
#undef SK_MMA
}
template <class Epi, class Sched, bool ALIGN_EPI = false, bool SP2 = false>
__device__ __forceinline__ void gemm_phase(PG8_LAS unsigned char* lds, const Gemm g, const Sched& S, const Epi& E, const int wid) {
    const int lane = lane_opaque(), tid = wid * 64 + lane, wr = wid >> 2, wc = wid & 3, fr = lane & 15, fq = lane >> 4;
    const int K = g.K, nt = K / BK;
    unsigned voffA[2], voffB[2];
#pragma unroll
    for (int i = 0; i < 2; ++i) { int R, C; stage_rc(tid * 16 + i * 8192, R, C); const int Rb = Epi::PERM ? ((R & ~31) + perm32(R & 31)) : R;
        voffA[i] = (unsigned)(R * K + C) * 2u; voffB[i] = (unsigned)(Rb * K + C) * 2u; }
    const size_t kstep = (size_t)(BK * 2);
    const size_t hstep = (size_t)HALF * K * 2;
    const size_t tstep = 2 * hstep;
    const unsigned ldsw = (unsigned)wid * 1024u;
    const int aoff = lds_byte(wr * 64 + fr, fq * 8), boff = lds_byte(wc * 32 + fr, fq * 8);
#define PG8_SA(b, h) (((b) * 2 + (h)) * HTB)
#define PG8_SB(b, h) ((4 + (b) * 2 + (h)) * HTB)
#define PG8_STAGE(bufoff, gbase, voff) do { _Pragma("unroll") for (int _i = 0; _i < 2; ++_i) \
        __builtin_amdgcn_global_load_lds((const unsigned*)((const char*)(gbase) + (voff)[_i]), (PG8_LAS unsigned*)(lds + (bufoff) + ldsw + _i * 8192), 16, 0, 0); } while (0)
#define PG8_LDA(dst, b, h) do { _Pragma("unroll") for (int m = 0; m < 4; ++m) _Pragma("unroll") for (int k = 0; k < 2; ++k) dst[m][k] = *(const PG8_LAS bf16x8*)(lds + PG8_SA(b, h) + aoff + m * 2048 + k * 1024); } while (0)
#define PG8_LDB(dst, b, h) do { _Pragma("unroll") for (int n = 0; n < 2; ++n) _Pragma("unroll") for (int k = 0; k < 2; ++k) dst[n][k] = *(const PG8_LAS bf16x8*)(lds + PG8_SB(b, h) + boff + n * 2048 + k * 1024); } while (0)
#define PG8_MMA(ai, bj, At, Bt) do { __builtin_amdgcn_s_setprio(1); _Pragma("unroll") for (int m = 0; m < 4; ++m) _Pragma("unroll") for (int n = 0; n < 2; ++n) _Pragma("unroll") for (int k = 0; k < 2; ++k) \
        acc[ai][bj][m][n] = __builtin_amdgcn_mfma_f32_16x16x32_bf16(Bt[n][k], At[m][k], acc[ai][bj][m][n], 0, 0, 0); __builtin_amdgcn_s_setprio(0); } while (0)
#define PG8_WAIT_V(n) asm volatile("s_waitcnt vmcnt(" #n ")" ::: "memory")
#define PG8_WAIT_L(n) asm volatile("s_waitcnt lgkmcnt(" #n ")" ::: "memory")
#define PG8_BAR __builtin_amdgcn_s_barrier()
#define PG8_SCHED __builtin_amdgcn_sched_barrier(0)
    Unit cur, nxt; int ui = 0;
    if (!S.next(0, cur)) return;
    f32x4 acc[2][2][4][2];
#pragma unroll
    for (int a = 0; a < 2; ++a)
#pragma unroll
        for (int b = 0; b < 2; ++b)
#pragma unroll
            for (int m = 0; m < 4; ++m)
#pragma unroll
                for (int n = 0; n < 2; ++n) acc[a][b][m][n] = (f32x4){0.f, 0.f, 0.f, 0.f};
    bf16x8 At[4][2], B0[2][2], B1[2][2];
    const char* cA = (const char*)g.A + (size_t)cur.pm * tstep; const char* cB = (const char*)g.Bt + (size_t)cur.pn * tstep;
    S.a_ready(cur);
    if constexpr (SP2) {
        PG8_STAGE(PG8_SB(0, 0), cB, voffB); PG8_STAGE(PG8_SB(0, 1), cB + hstep, voffB); PG8_STAGE(PG8_SA(0, 0), cA, voffA); PG8_STAGE(PG8_SA(0, 1), cA + hstep, voffA);
        if (wr == 1) PG8_BAR;
        PG8_WAIT_V(2); PG8_BAR;
        PG8_STAGE(PG8_SB(1, 0), cB + kstep, voffB); PG8_STAGE(PG8_SA(1, 0), cA + kstep, voffA); PG8_STAGE(PG8_SB(1, 1), cB + hstep + kstep, voffB);
        PG8_WAIT_V(6); PG8_BAR;
    } else {
        PG8_STAGE(PG8_SB(0, 0), cB, voffB); PG8_STAGE(PG8_SA(0, 0), cA, voffA); PG8_STAGE(PG8_SB(0, 1), cB + hstep, voffB); PG8_STAGE(PG8_SA(0, 1), cA + hstep, voffA);
        if (wr == 1) PG8_BAR;
        PG8_WAIT_V(4); PG8_BAR;
        PG8_STAGE(PG8_SB(1, 0), cB + kstep, voffB); PG8_STAGE(PG8_SA(1, 0), cA + kstep, voffA); PG8_STAGE(PG8_SB(1, 1), cB + hstep + kstep, voffB);
        PG8_WAIT_V(6); PG8_BAR;
    }
    for (;;) {
        const bool has_next = S.next(ui + 1, nxt);
        const char* nA = has_next ? (const char*)g.A + (size_t)nxt.pm * tstep : cA; const char* nB = has_next ? (const char*)g.Bt + (size_t)nxt.pn * tstep : cB;
        for (int t = 0; t < nt; t += 2) {
            const bool last = (t == nt - 2);
            const char* a1 = cA + (size_t)(t + 1) * kstep;
            const char* a2 = last ? nA : cA + (size_t)(t + 2) * kstep; const char* b2 = last ? nB : cB + (size_t)(t + 2) * kstep;
            const char* a3 = a2 + kstep; const char* b3 = b2 + kstep;
            if (last && has_next) S.a_ready(nxt);
            if constexpr (SP2) {
            PG8_LDB(B0, 0, 0); PG8_LDB(B1, 0, 1); PG8_SCHED; PG8_LDA(At, 0, 0); PG8_STAGE(PG8_SA(1, 1), a1 + hstep, voffA);
            PG8_WAIT_V(8); PG8_WAIT_L(0); PG8_BAR; PG8_MMA(0, 0, At, B0); PG8_MMA(0, 1, At, B1); PG8_BAR; PG8_SCHED;
            PG8_LDA(At, 0, 1); PG8_STAGE(PG8_SB(0, 0), b2, voffB); PG8_STAGE(PG8_SB(0, 1), b2 + hstep, voffB); PG8_STAGE(PG8_SA(0, 0), a2, voffA);
            PG8_WAIT_V(8); PG8_WAIT_L(0); PG8_BAR; PG8_MMA(1, 0, At, B0); PG8_MMA(1, 1, At, B1); PG8_BAR; PG8_SCHED;
            PG8_LDB(B0, 1, 0); PG8_LDB(B1, 1, 1); PG8_SCHED; PG8_LDA(At, 1, 0); PG8_STAGE(PG8_SA(0, 1), a2 + hstep, voffA);
            PG8_WAIT_V(8); PG8_WAIT_L(0); PG8_BAR; PG8_MMA(0, 0, At, B0); PG8_MMA(0, 1, At, B1); PG8_BAR; PG8_SCHED;
            PG8_LDA(At, 1, 1); PG8_STAGE(PG8_SB(1, 0), b3, voffB); PG8_STAGE(PG8_SB(1, 1), b3 + hstep, voffB); PG8_STAGE(PG8_SA(1, 0), a3, voffA);
            PG8_WAIT_V(8); PG8_WAIT_L(0); PG8_BAR; PG8_MMA(1, 0, At, B0); PG8_MMA(1, 1, At, B1); PG8_BAR; PG8_SCHED;
            } else {
            PG8_LDB(B0, 0, 0); PG8_SCHED; PG8_LDA(At, 0, 0); PG8_STAGE(PG8_SA(1, 1), a1 + hstep, voffA);
            PG8_WAIT_L(8); PG8_BAR; PG8_WAIT_L(0); PG8_MMA(0, 0, At, B0); PG8_BAR; PG8_SCHED;
            PG8_LDB(B1, 0, 1); PG8_STAGE(PG8_SB(0, 0), b2, voffB);
            PG8_BAR; PG8_WAIT_L(0); PG8_MMA(0, 1, At, B1); PG8_BAR;
            PG8_LDA(At, 0, 1); PG8_STAGE(PG8_SA(0, 0), a2, voffA);
            PG8_BAR; PG8_WAIT_L(0); PG8_MMA(1, 0, At, B0); PG8_BAR; PG8_SCHED;
            PG8_STAGE(PG8_SB(0, 1), b2 + hstep, voffB);
            PG8_WAIT_V(6); PG8_BAR; PG8_MMA(1, 1, At, B1); PG8_BAR;
            PG8_LDB(B0, 1, 0); PG8_SCHED; PG8_LDA(At, 1, 0); PG8_STAGE(PG8_SA(0, 1), a2 + hstep, voffA);
            PG8_WAIT_L(8); PG8_BAR; PG8_WAIT_L(0); PG8_MMA(0, 0, At, B0); PG8_BAR; PG8_SCHED;
            PG8_LDB(B1, 1, 1); PG8_STAGE(PG8_SB(1, 0), b3, voffB);
            PG8_BAR; PG8_WAIT_L(0); PG8_MMA(0, 1, At, B1); PG8_BAR;
            PG8_LDA(At, 1, 1); PG8_STAGE(PG8_SA(1, 0), a3, voffA);
            PG8_BAR; PG8_WAIT_L(0); PG8_MMA(1, 0, At, B0); PG8_BAR; PG8_SCHED;
            PG8_STAGE(PG8_SB(1, 1), b3 + hstep, voffB);
            PG8_WAIT_V(6); PG8_BAR; PG8_MMA(1, 1, At, B1); PG8_BAR;
            }
        }
        if constexpr (ALIGN_EPI) { if (wr == 0) PG8_BAR; }
        if constexpr (!Epi::AFTER_DRAIN) { E(acc, cur, wr, wc, fr, fq);
#ifdef XEPI2
            for (int q_ = 0; q_ < XEPI2; ++q_) { asm volatile("" ::: "memory"); E(acc, cur, wr, wc, fr, fq); }
#endif
            S.done(cur); }
        if (!has_next) break;
#pragma unroll
        for (int a = 0; a < 2; ++a)
#pragma unroll
            for (int b = 0; b < 2; ++b)
#pragma unroll
                for (int m = 0; m < 4; ++m)
#pragma unroll
                    for (int n = 0; n < 2; ++n) acc[a][b][m][n] = (f32x4){0.f, 0.f, 0.f, 0.f};
        cur = nxt; cA = nA; cB = nB; ++ui;
        if constexpr (ALIGN_EPI) { if (wr == 1) PG8_BAR; }
    }
    PG8_WAIT_V(0);
    if constexpr (!ALIGN_EPI) { if (wr == 0) PG8_BAR; }
    PG8_BAR;
    if constexpr (Epi::AFTER_DRAIN) { E.fused(acc, cur, wr, wc, fr, fq, lds, wid, lane); S.done(cur); }
#undef PG8_SA
#undef PG8_SB
#undef PG8_STAGE
#undef PG8_LDA
#undef PG8_LDB
#undef PG8_MMA
#undef PG8_WAIT_V
#undef PG8_WAIT_L
#undef PG8_BAR
#undef PG8_SCHED
}
}
namespace att {
using bf16 = __hip_bfloat16;
typedef short bf16x8 __attribute__((ext_vector_type(8)));
typedef short s16x4 __attribute__((ext_vector_type(4)));
typedef float f32x16 __attribute__((ext_vector_type(16)));
typedef float f32x4 __attribute__((ext_vector_type(4)));
typedef unsigned u32x4 __attribute__((ext_vector_type(4)));
template <class A, class Bt> struct same_t { static constexpr bool v = false; };
template <class A> struct same_t<A, A> { static constexpr bool v = true; };

#define KSWZ(row, colB) ((row) * 256 + ((colB) ^ (((row) & 7) << 4)))
#define SBAR() __builtin_amdgcn_sched_barrier(0)
__device__ __forceinline__ int v_st(int k, int c) { const int kk = (k & ~0xC) | ((k & 4) << 1) | ((k & 8) >> 1); return ((kk >> 3) * 4 + (c >> 5)) * 512 + ((kk & 7) * 32 + (c & 31)) * 2; }
__device__ __forceinline__ int v_rd_base(int lane) { return ((lane & 3) << 3) | (((lane >> 2) & 3) << 6) | (((lane >> 4) & 1) << 5) | (((lane >> 5) & 1) << 8); }
constexpr int v_rd_off(int d0, int ks, int half) { return d0 * 512 + ks * 4096 + half * 2048; }
__device__ __forceinline__ int crow(int r, int hi) { return (r & 3) + 8 * (r >> 2) + 4 * hi; }
__device__ __forceinline__ unsigned cvtpk(float lo, float hi) {
    unsigned r; asm volatile("v_cvt_pk_bf16_f32 %0, %1, %2" : "=v"(r) : "v"(lo), "v"(hi)); return r;
}
__device__ __forceinline__ bf16x8 pack8(f32x4 a, f32x4 b) {
    u32x4 w = {cvtpk(a[0], a[1]), cvtpk(a[2], a[3]), cvtpk(b[0], b[1]), cvtpk(b[2], b[3])};
    return *reinterpret_cast<bf16x8*>(&w);
}
template <class T> __device__ __forceinline__ bf16x8 load8(const T* p) {
    if constexpr (same_t<T, float>::v) { return pack8(*(const f32x4*)p, *(const f32x4*)(p + 4)); }
    else { return *reinterpret_cast<const bf16x8*>(p); }
}
__device__ __forceinline__ void mask_tile(f32x16& p0, f32x16& p1, int dq, unsigned W) {
    const float NEG = -__builtin_inff();
#pragma unroll
    for (int r = 0; r < 16; ++r) {
        const int c = (r & 3) + 8 * (r >> 2);
        if ((unsigned)(dq - c) >= W) p0[r] = NEG;
        if ((unsigned)(dq - c - 32) >= W) p1[r] = NEG;
    }
}
constexpr int SHM_V = 16384;
template <int DQK> struct ACfg { static constexpr float SCALE = DQK == 192 ? 0.07216878364870323f : 0.08838834764831845f; };
constexpr float THR = 8.f;
template <int DQK>
__device__ __forceinline__ void partialSM(f32x16& p0, f32x16& p1, float& m_reg, float& mn, float& alpha) {
    constexpr float SCALE = ACfg<DQK>::SCALE;
    float pmax = p0[0]; for (int r = 1; r < 16; ++r) pmax = fmaxf(pmax, p0[r]); for (int r = 0; r < 16; ++r) pmax = fmaxf(pmax, p1[r]);
    { auto rr = __builtin_amdgcn_permlane32_swap(__float_as_uint(pmax), __float_as_uint(pmax), false, false);
      pmax = fmaxf(__uint_as_float(rr[0]), __uint_as_float(rr[1])); }
    constexpr float C2 = 1.4426950408889634f * SCALE;
    if (__builtin_expect(__all((pmax - m_reg) * SCALE <= THR), 1)) { mn = m_reg; alpha = 1.f; }
    else { mn = fmaxf(m_reg, pmax); alpha = __builtin_amdgcn_exp2f((m_reg - mn) * C2); m_reg = mn; }
    const float mnL = -mn * C2;
    for (int r = 0; r < 16; ++r) p0[r] = fmaf(p0[r], C2, mnL); for (int r = 0; r < 16; ++r) p1[r] = fmaf(p1[r], C2, mnL);
    for (int r = 0; r < 16; ++r) p0[r] = __builtin_amdgcn_exp2f(p0[r]);
}
template <int DQK, bool FOX>
__device__ __forceinline__ void qkt(f32x16& p0, f32x16& p1, const char* kl, const float* cb  , int r32, int hi, const bf16x8* qr) {
    if constexpr (FOX) {
#pragma unroll
        for (int i = 0; i < 4; ++i) { const f32x4 a = *(const f32x4*)(cb + 8 * i), b = *(const f32x4*)(cb + 32 + 8 * i);
            p0[4 * i] = a[0]; p0[4 * i + 1] = a[1]; p0[4 * i + 2] = a[2]; p0[4 * i + 3] = a[3];
            p1[4 * i] = b[0]; p1[4 * i + 1] = b[1]; p1[4 * i + 2] = b[2]; p1[4 * i + 3] = b[3]; }
    } else { p0 = f32x16{}; p1 = f32x16{}; }
    const char* krow = kl + r32 * 256; const int x16 = (r32 & 15) << 4;
#pragma unroll
    for (int d0 = 0; d0 < 8; ++d0) { const char* a = krow + (((d0 * 2 + hi) << 4) ^ x16);
        bf16x8 b0 = *reinterpret_cast<const bf16x8*>(a);
        bf16x8 b1 = *reinterpret_cast<const bf16x8*>(a + 32 * 256);
        p0 = __builtin_amdgcn_mfma_f32_32x32x16_bf16(b0, qr[d0], p0, 0, 0, 0);
        p1 = __builtin_amdgcn_mfma_f32_32x32x16_bf16(b1, qr[d0], p1, 0, 0, 0); }
    if constexpr (DQK == 192) {
        const char* rrow = kl + 16384 + r32 * 128; const int x8 = ((r32 >> 1) & 7) << 4;
#pragma unroll
        for (int d0 = 0; d0 < 4; ++d0) { const char* a = rrow + (((d0 * 2 + hi) << 4) ^ x8);
            bf16x8 b0 = *reinterpret_cast<const bf16x8*>(a);
            bf16x8 b1 = *reinterpret_cast<const bf16x8*>(a + 32 * 128);
            p0 = __builtin_amdgcn_mfma_f32_32x32x16_bf16(b0, qr[8 + d0], p0, 0, 0, 0);
            p1 = __builtin_amdgcn_mfma_f32_32x32x16_bf16(b1, qr[8 + d0], p1, 0, 0, 0); }
    }
}
__device__ __forceinline__ void finishSM(f32x16& p0, f32x16& p1, float alpha, float& l_reg, bf16x8& pa0, bf16x8& pa1, bf16x8& pa2, bf16x8& pa3) {
    for (int r = 0; r < 16; ++r) p1[r] = __builtin_amdgcn_exp2f(p1[r]);
    float ps = 0; for (int r = 0; r < 16; ++r) ps += p0[r]; for (int r = 0; r < 16; ++r) ps += p1[r];
    { auto rr = __builtin_amdgcn_permlane32_swap(__float_as_uint(ps), __float_as_uint(ps), false, false);
      ps = __uint_as_float(rr[0]) + __uint_as_float(rr[1]); }
    l_reg = l_reg * alpha + ps;
#define PK4(P, B_, OUT) do { unsigned a0 = cvtpk(P[B_+0], P[B_+1]), a1 = cvtpk(P[B_+2], P[B_+3]);                          \
        unsigned b0 = cvtpk(P[B_+4], P[B_+5]), b1 = cvtpk(P[B_+6], P[B_+7]);                                             \
        auto r0 = __builtin_amdgcn_permlane32_swap(a0, b0, false, false); auto r1 = __builtin_amdgcn_permlane32_swap(a1, b1, false, false); \
        u32x4 w = {r0[0], r1[0], r0[1], r1[1]}; OUT = *reinterpret_cast<bf16x8*>(&w); } while (0)
    PK4(p0, 0, pa0); PK4(p0, 8, pa1); PK4(p1, 0, pa2); PK4(p1, 8, pa3);
#undef PK4
}
__device__ __forceinline__ void pv_tile(f32x16* o, int vb0  , bf16x8 pa0, bf16x8 pa1, bf16x8 pa2, bf16x8 pa3) {
#define TRRD(dst, off) asm volatile("ds_read_b64_tr_b16 %0, %1 offset:%2" : "=&v"(dst) : "v"(vb0), "i"(off) : "memory")
#define PV_RD(L, H, ks) do { constexpr int b_ = (ks) * 4096; TRRD(L[0], b_); TRRD(H[0], b_ + 2048); TRRD(L[1], b_ + 512); TRRD(H[1], b_ + 512 + 2048); \
        TRRD(L[2], b_ + 1024); TRRD(H[2], b_ + 1024 + 2048); TRRD(L[3], b_ + 1536); TRRD(H[3], b_ + 1536 + 2048); } while (0)
#define PV_MM(L, H, pa) do { _Pragma("unroll") for (int d0 = 0; d0 < 4; ++d0) \
        o[d0] = __builtin_amdgcn_mfma_f32_32x32x16_bf16(pa, (bf16x8){L[d0][0], L[d0][1], L[d0][2], L[d0][3], H[d0][0], H[d0][1], H[d0][2], H[d0][3]}, o[d0], 0, 0, 0); } while (0)
#define PV_WAIT(n) do { asm volatile("s_waitcnt lgkmcnt(" #n ")" ::: "memory"); SBAR(); } while (0)
    s16x4 la[4], ha[4], lb[4], hb[4];
    PV_RD(la, ha, 0); PV_RD(lb, hb, 1);
    PV_WAIT(8); PV_MM(la, ha, pa0); SBAR();
    PV_RD(la, ha, 2);
    PV_WAIT(8); PV_MM(lb, hb, pa1); SBAR();
    PV_RD(lb, hb, 3);
    PV_WAIT(8); PV_MM(la, ha, pa2); SBAR();
    PV_WAIT(0); PV_MM(lb, hb, pa3);
#undef PV_RD
#undef PV_MM
#undef PV_WAIT
#undef TRRD
}
constexpr int SEQ = 4096, NHEAD = 16, TOKP = 2048;
template <int DQK, bool FOX>
__device__ __forceinline__ void attn_phase(char* lds, LAS unsigned char* ldsl, const bf16* __restrict__ Q, const bf16* __restrict__ Kn, const bf16* __restrict__ Kr, const bf16* __restrict__ V,
                                           bf16* __restrict__ O, const float* __restrict__ logf, int G, int bid, const int wid) {
    constexpr int QP = NHEAD * DQK;
    constexpr int SLOT = DQK == 192 ? 40960 : 32768;
    constexpr int VOFF = DQK == 192 ? 24576 : 16384;
    const int lane = lane_opaque(), tid = wid * 64 + lane, r32 = lane & 31, hi = lane >> 5;
    float* wsb = (float*)(lds + 3 * SLOT); float* ws = wsb + wid * 64; float* li_l = ws; float* al_l = ws + 32;
    float* Cb = wsb + 8 * 64;
    float* scn = Cb + 4096;
    unsigned koff0, koff1, voff0, voff1, roff;
    { const int q0 = wid * 128 + lane, q1 = q0 + 64;
      { const int row = q0 >> 4, src = (q0 & 15) ^ (row & 15); koff0 = (unsigned)(row * TOKP + src * 8) * 2u; }
      { const int row = q1 >> 4, src = (q1 & 15) ^ (row & 15); koff1 = (unsigned)(row * TOKP + src * 8) * 2u; }
      { const int s = q0 >> 5, w = q0 & 31, kk = (s >> 2) * 8 + (w >> 2), c = (s & 3) * 32 + (w & 3) * 8, k = (kk & ~0xC) | ((kk & 4) << 1) | ((kk & 8) >> 1); voff0 = (unsigned)(k * TOKP + c) * 2u; }
      { const int s = q1 >> 5, w = q1 & 31, kk = (s >> 2) * 8 + (w >> 2), c = (s & 3) * 32 + (w & 3) * 8, k = (kk & ~0xC) | ((kk & 4) << 1) | ((kk & 8) >> 1); voff1 = (unsigned)(k * TOKP + c) * 2u; }
      { const int q = wid * 64 + lane, row = q >> 3, src = (q & 7) ^ ((row >> 1) & 7); roff = (unsigned)(row * 64 + src * 8) * 2u; } }
    const int vrd = (int)(uintptr_t)lds + VOFF + v_rd_base(lane);
#define A_GLDS(gp_, lp_) __builtin_amdgcn_global_load_lds((const unsigned*)(gp_), (LAS unsigned*)(lp_), 16, 0, 0)
#define A_DMA(kb_, slot_) do { LAS unsigned char* d_ = ldsl + (slot_) * SLOT + wid * 2048; const char* kg_ = (const char*)(Kh + (size_t)(kb_) * TOKP); const char* vg_ = (const char*)(Vh + (size_t)(kb_) * TOKP); \
        A_GLDS(kg_ + koff0, d_); A_GLDS(kg_ + koff1, d_ + 1024);                                                        \
        if constexpr (DQK == 192) A_GLDS((const char*)(Krh + (size_t)(kb_) * 64) + roff, ldsl + (slot_) * SLOT + 16384 + wid * 1024); \
        A_GLDS(vg_ + voff0, d_ + VOFF); A_GLDS(vg_ + voff1, d_ + VOFF + 1024); } while (0)
#define A_BAR() do { asm volatile("s_waitcnt lgkmcnt(0)" ::: "memory"); __builtin_amdgcn_s_barrier(); asm volatile("" ::: "memory"); } while (0)
#define A_VMW(n) do { if constexpr (DQK == 192) { if ((n) == 1) asm volatile("s_waitcnt vmcnt(5)" ::: "memory"); else asm volatile("s_waitcnt vmcnt(0)" ::: "memory"); } \
                      else { if ((n) == 1) asm volatile("s_waitcnt vmcnt(4)" ::: "memory"); else asm volatile("s_waitcnt vmcnt(0)" ::: "memory"); } } while (0)
    for (int L = bid; L < 512; L += G) {
        const int xcd = L & 7, idx = L >> 3, bh = xcd + 8 * (idx >> 3), x = idx & 7, b = bh >> 4, h = bh & 15;
        const size_t row0 = (size_t)b * SEQ;
        const bf16* Kh = Kn + row0 * TOKP + h * 128; const bf16* Vh = V + row0 * TOKP + h * 128; const bf16* Krh = Kr + row0 * 64;
        for (int pass = 0; pass < 2; ++pass) {
            const int qb = pass ? 15 - x : x, P0 = qb * 256, NT = P0 / 64 + 4;
            __syncthreads();
            A_DMA(0, 0); A_DMA(64, 1);
            if constexpr (FOX) {
                float v[8]; float s = 0.f; const int k0 = tid * 8; const bool on = k0 < P0 + 256;
#pragma unroll
                for (int j = 0; j < 8; ++j) { v[j] = on ? logf[(row0 + k0 + j) * 16 + h] : 0.f; }
#pragma unroll
                for (int j = 0; j < 8; ++j) { s += v[j]; v[j] = s; }
                float inc = s;
#pragma unroll
                for (int o_ = 1; o_ < 64; o_ <<= 1) { const float t_ = __shfl_up(inc, o_); if (lane >= o_) inc += t_; }
                if (lane == 63) scn[wid] = inc;
                __syncthreads();
                float base = inc - s;
                for (int w_ = 0; w_ < wid; ++w_) base += scn[w_];
                if (on) {
#pragma unroll
                    for (int j = 0; j < 8; ++j) Cb[k0 + j] = -(base + v[j]) * 11.313708498984761f;
                }
            }
            bf16x8 qr[DQK / 16];
            { int qoff = r32 * QP + hi * 8; asm volatile("" : "+v"(qoff));
              const bf16* qp = Q + (row0 + P0 + wid * 32) * QP + h * DQK + qoff;
#pragma unroll
              for (int d0 = 0; d0 < DQK / 16; ++d0) qr[d0] = *reinterpret_cast<const bf16x8*>(qp + d0 * 16); }
            asm volatile("s_waitcnt vmcnt(0)" ::: "memory");
#pragma unroll
            for (int d0 = 0; d0 < DQK / 16; ++d0) asm volatile("" : "+v"(qr[d0]));
            A_BAR();
            const int qlo = P0 + wid * 32, qloE = FOX ? qlo : (qlo | 63), qhiE = FOX ? qlo + 31 : (qlo | 63), qm = (FOX ? (qlo + r32) : ((qlo + r32) | 63)) - 4 * hi;
            float m_reg = -1e30f, l_reg = 0.f; f32x16 o[4] = {};
            f32x16 p0, p1; float mn, alpha; bf16x8 pa0, pa1, pa2, pa3;
#define A_RESC(a) do { if (__any((a) < 1.f)) { if (hi == 0) al_l[r32] = (a); asm volatile("s_waitcnt lgkmcnt(0)" ::: "memory");              \
                     for (int d_ = 0; d_ < 4; ++d_) for (int r = 0; r < 16; ++r) o[d_][r] *= al_l[crow(r, hi)]; } } while (0)
            int sc = 0, s2 = 2;
#pragma unroll 1
            for (int t = 0; t < NT; ++t) { const int kb_ = t * 64; const int kn_ = (t + 2 < NT ? t + 2 : NT - 1) * 64;
                const bool act_ = kb_ <= qhiE;
                if (act_) { SBAR(); qkt<DQK, FOX>(p0, p1, lds + sc * SLOT, Cb + kb_ + 4 * hi, r32, hi, qr); SBAR(); }
                A_DMA(kn_, s2);
                SBAR();
                if (act_) { if (kb_ + 63 > qloE) mask_tile(p0, p1, qm - kb_, 1u << 30);
                    partialSM<DQK>(p0, p1, m_reg, mn, alpha); finishSM(p0, p1, alpha, l_reg, pa0, pa1, pa2, pa3);
                    A_RESC(alpha); SBAR();
                    pv_tile(o, vrd + sc * SLOT, pa0, pa1, pa2, pa3); SBAR(); }
                A_VMW(1);
                A_BAR();
                sc = sc == 2 ? 0 : sc + 1; s2 = s2 == 2 ? 0 : s2 + 1; }
            A_VMW(0);
            if (hi == 0) li_l[r32] = l_reg; asm volatile("s_waitcnt lgkmcnt(0)" ::: "memory");
            bf16* Ow = O + (row0 + P0 + wid * 32) * TOKP + h * 128;
            int obase = hi * 4 * TOKP + r32; asm volatile("" : "+v"(obase));
#pragma unroll
            for (int r = 0; r < 16; ++r) { const int orow = (r & 3) + 8 * (r >> 2); const float rl = __builtin_amdgcn_rcpf(li_l[orow + 4 * hi]);
#pragma unroll
                for (int d0 = 0; d0 < 4; ++d0) { const float v = o[d0][r] * rl; const float vn = __shfl_xor(v, 1);
                    if ((r32 & 1) == 0) *(unsigned*)(Ow + obase + orow * TOKP + d0 * 32) = cvtpk(v, vn); } }
#undef A_RESC
        }
    }
#undef A_GLDS
#undef A_DMA
#undef A_BAR
#undef A_VMW
}
#undef SBAR
}
typedef unsigned short bf16_t;
typedef float f32x4 __attribute__((ext_vector_type(4)));
typedef unsigned u32x4 __attribute__((ext_vector_type(4)));
typedef unsigned u32x2 __attribute__((ext_vector_type(2)));
constexpr int M = 16384, DM = 2048, FFH = 5632, NPH = 17;
constexpr float ALPHA = 1.4142135623730951f;
constexpr size_t MiB = 1u << 20;
constexpr size_t WS_WIN0 = 1 * MiB, WS_WQUP = 6 * MiB, WS_WKVUP = 9 * MiB, WS_WO0 = 13 * MiB, WS_WIN1 = 21 * MiB, WS_WO1 = 46 * MiB,
                 WS_WGU0 = 54 * MiB, WS_WGU1 = 98 * MiB, WS_WDN0 = 142 * MiB, WS_WDN1 = 164 * MiB, WS_TAB = 186 * MiB, WS_LOGF = 190 * MiB,
                 WS_PART = 191 * MiB, WS_XB = 192 * MiB, WS_R = 256 * MiB;
constexpr size_t WS_Q = WS_R, WS_H0 = WS_R, WS_K = WS_R + 96 * MiB, WS_V = WS_R + 160 * MiB, WS_O = WS_R + 224 * MiB, WS_CQN = WS_R + 288 * MiB, WS_CKVN = WS_R + 304 * MiB, WS_KROPE = WS_R + 320 * MiB;
constexpr size_t WS_FQ = WS_R, WS_FK = WS_R + 64 * MiB, WS_FV = WS_R + 128 * MiB, WS_HFF = WS_R;
constexpr int LDS_BYTES = 147456;
#ifndef GALIGN
#define GALIGN true
#endif
#ifndef GSP2
#define GSP2 true
#endif

__device__ __forceinline__ unsigned cvtpk2(float lo, float hi) { unsigned r; asm volatile("v_cvt_pk_bf16_f32 %0, %1, %2" : "=v"(r) : "v"(lo), "v"(hi)); return r; }
__device__ __forceinline__ float wave_sum(float v) {
#pragma unroll
    for (int o = 1; o < 64; o <<= 1) v += __shfl_xor(v, o);
    return v;
}
__device__ __forceinline__ void transpose_item(const float* __restrict__ W, int K, int nsrc, int ndst, bf16_t* __restrict__ WT, LAS unsigned char* scr, int item, int lane, int kind) {
    const int nblk = ndst / 64, kb = item / nblk, nb = item - kb * nblk, k0 = 128 * kb, n0 = 64 * nb;
    int src0 = n0; bool ropeblk = false;
    if (kind == 2) { const int t = n0 >> 8, bj = (n0 >> 7) & 1, j = n0 & 127; src0 = bj * FFH + t * 128 + j; }
    if (kind == 1) ropeblk = (n0 % 192) == 128;
    const int nn = (lane & 15) * 4, kp = lane >> 4; const bool valid = src0 + nn < nsrc;
    int pr[4];
#pragma unroll
    for (int e = 0; e < 4; ++e) { const int j = nn + e; pr[e] = (ropeblk ? (j < 32 ? 2 * j : 2 * (j - 32) + 1) : j) * 272 + kp * 4; }
    const float* wp = W + (size_t)(k0 + 2 * kp) * nsrc + src0 + nn;
#pragma unroll
    for (int h = 0; h < 2; ++h) { f32x4 va[8], vb[8];
#pragma unroll
        for (int i = 0; i < 8; ++i) { va[i] = (f32x4){0.f, 0.f, 0.f, 0.f}; vb[i] = va[i];
            if (valid) { const float* p = wp + (size_t)(8 * (8 * h + i)) * nsrc; va[i] = *(const f32x4*)p; vb[i] = *(const f32x4*)(p + nsrc); } }
#pragma unroll
        for (int i = 0; i < 8; ++i) { const int ko = (8 * h + i) * 16;
            *(LAS unsigned*)(scr + pr[0] + ko) = cvtpk2(va[i][0], vb[i][0]); *(LAS unsigned*)(scr + pr[1] + ko) = cvtpk2(va[i][1], vb[i][1]);
            *(LAS unsigned*)(scr + pr[2] + ko) = cvtpk2(va[i][2], vb[i][2]); *(LAS unsigned*)(scr + pr[3] + ko) = cvtpk2(va[i][3], vb[i][3]); } }
    asm volatile("s_waitcnt lgkmcnt(0)" ::: "memory");
#pragma unroll
    for (int j = 0; j < 16; ++j) { const int q = j * 64 + lane, row = q >> 4, c = q & 15;
        const u32x4 o = *(const LAS u32x4*)(scr + row * 272 + c * 16);
        *(u32x4*)(WT + (size_t)(n0 + row) * K + k0 + 8 * c) = o; }
    asm volatile("s_waitcnt lgkmcnt(0)" ::: "memory");
}
__device__ const float INV_FREQ[32] = {1.0f, 0.7498942017555237f, 0.5623413324356079f, 0.4216965138912201f, 0.3162277638912201f, 0.23713737726211548f, 0.17782793939113617f, 0.1333521455526352f, 0.10000000149011612f, 0.0749894231557846f, 0.05623413249850273f, 0.04216964915394783f, 0.03162277489900589f, 0.023713737726211548f, 0.017782794311642647f, 0.013335213996469975f, 0.009999999776482582f, 0.007498942315578461f, 0.005623413249850273f, 0.0042169648222625256f, 0.003162277629598975f, 0.0023713738191872835f, 0.0017782794311642647f, 0.0013335214462131262f, 0.0010000000474974513f, 0.0007498941849917173f, 0.000562341301701963f, 0.0004216965171508491f, 0.0003162277571391314f, 0.00023713737027719617f, 0.00017782794020604342f, 0.0001333521504420787f};

struct Args { const float* in[17]; const int* pos; float* out; unsigned char* ws; int ph_lo, ph_hi; };

__device__ __forceinline__ void phase_prep(const Args& a, unsigned char* ws, LAS unsigned char* ldsl, int bid, int G, int tid, int wid, int lane) {
    LAS unsigned char* scr = ldsl + wid * 17408;
    const int gw = bid * 8 + wid, NGW = G * 8;
    constexpr int I0 = 16 * 20, I1 = 4 * 48, I2 = 4 * 64, I3 = 16 * 32, I4 = 16 * 97, I5 = 16 * 32, I6 = 16 * 176, I8 = 44 * 32;
    constexpr int NIT = I0 + I1 + I2 + I3 + I4 + I5 + 2 * I6 + 2 * I8;
    for (int it = gw; it < NIT; it += NGW) {
        int r = it;
        if (r < I6) { transpose_item(a.in[11], 2048, 11264, 11264, (bf16_t*)(ws + WS_WGU0), scr, r, lane, 2); continue; } r -= I6;
        if (r < I6) { transpose_item(a.in[11] + (size_t)2048 * 11264, 2048, 11264, 11264, (bf16_t*)(ws + WS_WGU1), scr, r, lane, 2); continue; } r -= I6;
        if (r < I8) { transpose_item(a.in[12], 5632, 2048, 2048, (bf16_t*)(ws + WS_WDN0), scr, r, lane, 0); continue; } r -= I8;
        if (r < I8) { transpose_item(a.in[12] + (size_t)5632 * 2048, 5632, 2048, 2048, (bf16_t*)(ws + WS_WDN1), scr, r, lane, 0); continue; } r -= I8;
        if (r < I4) { transpose_item(a.in[8], 2048, 6160, 6208, (bf16_t*)(ws + WS_WIN1), scr, r, lane, 0); continue; } r -= I4;
        if (r < I0) { transpose_item(a.in[2], 2048, 1088, 1280, (bf16_t*)(ws + WS_WIN0), scr, r, lane, 0); continue; } r -= I0;
        if (r < I1) { transpose_item(a.in[4], 512, 3072, 3072, (bf16_t*)(ws + WS_WQUP), scr, r, lane, 1); continue; } r -= I1;
        if (r < I2) { transpose_item(a.in[6], 512, 4096, 4096, (bf16_t*)(ws + WS_WKVUP), scr, r, lane, 0); continue; } r -= I2;
        if (r < I3) { transpose_item(a.in[7], 2048, 2048, 2048, (bf16_t*)(ws + WS_WO0), scr, r, lane, 0); continue; } r -= I3;
        transpose_item(a.in[10], 2048, 2048, 2048, (bf16_t*)(ws + WS_WO1), scr, r, lane, 0);
    }
    { const f32x4* x4 = (const f32x4*)a.in[0]; u32x4* o = (u32x4*)(ws + WS_XB); const size_t n8 = (size_t)M * DM / 8;
      const size_t stride = (size_t)G * 512;
      for (size_t i = (size_t)bid * 512 + tid; i < n8; i += 4 * stride) { f32x4 v0[4], v1[4];
#pragma unroll
          for (int u = 0; u < 4; ++u) { const size_t j = i + u * stride; if (j < n8) { v0[u] = x4[2 * j]; v1[u] = x4[2 * j + 1]; } }
#pragma unroll
          for (int u = 0; u < 4; ++u) { const size_t j = i + u * stride; if (j < n8) { u32x4 w; w.x = cvtpk2(v0[u][0], v0[u][1]); w.y = cvtpk2(v0[u][2], v0[u][3]); w.z = cvtpk2(v1[u][0], v1[u][1]); w.w = cvtpk2(v1[u][2], v1[u][3]); o[j] = w; } } } }
    { float* tab = (float*)(ws + WS_TAB);
      for (int i = bid * 512 + tid; i < M * 32; i += G * 512) { const int row = i >> 5, j = i & 31;
          const float ang = (float)a.pos[row] * INV_FREQ[j]; const double ad = (double)ang;
          const double kq = __builtin_rint(ad * 0.15915494309189535); const float rf = (float)__builtin_fma(-kq, 6.283185307179586, ad);
          tab[2 * (size_t)i] = cosf(rf); tab[2 * (size_t)i + 1] = sinf(rf); } }
}
__device__ __forceinline__ void phase_ln(float* XR, bf16_t* xb, const float* __restrict__ g, const float* __restrict__ bta, int bid, int G, int wid, int lane) {
    const int gw = bid * 8 + wid, NGW = G * 8;
    for (int row = gw; row < M; row += NGW) {
        f32x4* xr = (f32x4*)(XR + (size_t)row * DM) + lane; f32x4 v[8]; float s = 0.f;
#pragma unroll
        for (int j = 0; j < 8; ++j) { v[j] = xr[64 * j]; s += (v[j][0] + v[j][1]) + (v[j][2] + v[j][3]); }
        const float mean = wave_sum(s) * (1.f / DM); float s2 = 0.f;
#pragma unroll
        for (int j = 0; j < 8; ++j) { v[j] = v[j] - mean; s2 += (v[j][0] * v[j][0] + v[j][1] * v[j][1]) + (v[j][2] * v[j][2] + v[j][3] * v[j][3]); }
        const float rstd = 1.0f / sqrtf(wave_sum(s2) * (1.f / DM) + 1e-5f);
        u32x2* ob = (u32x2*)(xb + (size_t)row * DM) + lane;
#pragma unroll
        for (int j = 0; j < 8; ++j) { const f32x4 gg = ((const f32x4*)g)[lane + 64 * j], bb = ((const f32x4*)bta)[lane + 64 * j]; const f32x4 y = v[j] * rstd * gg + bb;
            xr[64 * j] = y; u32x2 w; w.x = cvtpk2(y[0], y[1]); w.y = cvtpk2(y[2], y[3]); ob[64 * j] = w; }
    }
}
__device__ __forceinline__ void phase_mla_norm(const float* __restrict__ h0, bf16_t* cqn, bf16_t* ckvn, bf16_t* krope, const float* __restrict__ gq, const float* __restrict__ gkv, const float* __restrict__ tab,
                                               int bid, int G, int wid, int lane) {
    const int gw = bid * 8 + wid, NGW = G * 8;
    for (int row = gw; row < M; row += NGW) {
        const float* hr = h0 + (size_t)row * 1280;
#pragma unroll
        for (int part = 0; part < 2; ++part) {
            const f32x4 a0 = *(const f32x4*)(hr + part * 512 + lane * 8), a1 = *(const f32x4*)(hr + part * 512 + lane * 8 + 4);
            float ss = (a0[0] * a0[0] + a0[1] * a0[1]) + (a0[2] * a0[2] + a0[3] * a0[3]) + (a1[0] * a1[0] + a1[1] * a1[1]) + (a1[2] * a1[2] + a1[3] * a1[3]);
            const float rstd = 1.0f / sqrtf(wave_sum(ss) * (1.f / 512.f) + 1e-6f);
            const float* gp = (part ? gkv : gq) + lane * 8; const f32x4 g0 = *(const f32x4*)gp, g1 = *(const f32x4*)(gp + 4);
            const f32x4 y0 = a0 * rstd * g0, y1 = a1 * rstd * g1;
            u32x4 w; w.x = cvtpk2(y0[0], y0[1]); w.y = cvtpk2(y0[2], y0[3]); w.z = cvtpk2(y1[0], y1[1]); w.w = cvtpk2(y1[2], y1[3]);
            *(u32x4*)((part ? ckvn : cqn) + (size_t)row * 512 + lane * 8) = w;
        }
        if (lane < 32) { const float t1 = hr[1024 + lane], t2 = hr[1024 + 32 + lane]; const float c = tab[((size_t)row * 32 + lane) * 2], s = tab[((size_t)row * 32 + lane) * 2 + 1];
            *(unsigned*)(krope + (size_t)row * 64 + 2 * lane) = cvtpk2(t1 * c - t2 * s, t2 * c + t1 * s); }
    }
}

__global__ void __launch_bounds__(512) mega_fwd(Args a) {
    extern __shared__ __attribute__((aligned(16))) unsigned char lds[];
    cg::grid_group grid = cg::this_grid();
    const int wid = __builtin_amdgcn_readfirstlane(threadIdx.x >> 6), G = gridDim.x, bid = blockIdx.x;
#define LANE_TID const int lane = lane_opaque(), tid = wid * 64 + lane; (void)tid
    unsigned char* ws = a.ws; LAS unsigned char* ldsl = (LAS unsigned char*)lds;
    const int lo = a.ph_lo, hi = a.ph_hi;
    float* XR = a.out; bf16_t* xb = (bf16_t*)(ws + WS_XB);
#ifndef PHMASK
#define PHMASK 0x1ffff
#endif
#define IN(k) (((PHMASK >> (k)) & 1) && lo <= (k) && (k) < hi)
    volatile LAS unsigned* bst = (volatile LAS unsigned*)(ldsl + LDS_BYTES - 64);
    { LANE_TID; if (tid < 2) bst[tid] = 0u; }
    __syncthreads();
    XcdBarrier bar; bar.bar = (unsigned*)ws; bar.x = 0; bar.st = bst;
#define SEAM(k) do { if ((k) + 1 < hi) { const bool t0_ = (wid == 0) && (lane_opaque() == 0); if ((k) == 0) { grid.sync(); bar = xcd_barrier_post((unsigned*)ws, bst, t0_); } else xcd_barrier(bar, t0_); } } while (0)
#ifndef REP_PH
#define REP_PH -1
#define REP_N 0
#endif
#define REPS(k) for (int rep_ = 0; rep_ < ((k) == REP_PH ? 1 + REP_N : 1); ++rep_)
#define GEMM(EpiT, E, Ap, Bp, N_, K_) do { pg8::Gemm g_{(const bf16_t*)(Ap), (const bf16_t*)(Bp), M, (N_), (K_)}; pg8::StaticOrder S_; S_.init(M, (N_), G, bid); \
        pg8::gemm_phase<EpiT, pg8::StaticOrder, GALIGN, GSP2>(ldsl, g_, S_, E, wid); } while (0)
    const bool fusedLN = (G == 256) && lo == 0 && hi == NPH;
#ifndef XSKIP
#define XSKIP -1
#endif
#ifndef XSKIPV
#define XSKIPV 0.f
#endif
#define GEMM_LN(ph_, basep, Ap, Bp, K_, gp, bp) do { _Pragma("unroll 1") for (int r_ = 0; r_ < 2; ++r_) { pg8::Gemm g_{(const bf16_t*)(Ap), (const bf16_t*)(Bp), M, 2048, (K_)}; pg8::PanelRound S_{r_, bid}; \
        pg8::EpiResidLN E_{(basep), XR, (ph_) == 15 ? (bf16_t*)nullptr : xb, (gp), (bp), (float*)(ws + WS_PART), bar, ALPHA, (ph_) == XSKIP ? XSKIPV : 1.f}; pg8::gemm_phase<pg8::EpiResidLN, pg8::PanelRound, false, GSP2>(ldsl, g_, S_, E_, wid); __syncthreads(); } } while (0)
    if (IN(0)) { LANE_TID; if (bid == 0) { for (int i = tid; i < XCD_BAR_WORDS; i += 512) __hip_atomic_store((unsigned*)ws + i, 0u, __ATOMIC_RELAXED, __HIP_MEMORY_SCOPE_AGENT); }
#ifdef XPREP2
                 for (int q_ = 0; q_ < XPREP2; ++q_) { phase_prep(a, ws, ldsl, bid, G, tid, wid, lane); __syncthreads(); }
#endif
                 phase_prep(a, ws, ldsl, bid, G, tid, wid, lane); SEAM(0); }
    if (IN(1)) REPS(1) {
        if (fusedLN) {
            { const int lane = lane_opaque(), fr = lane & 15, fq = lane >> 4, hf = wid & 1; const float* tab = (const float*)(ws + WS_TAB); bf16_t* krope = (bf16_t*)(ws + WS_KROPE);
              for (int rg = bid * 4 + (wid >> 1); rg < M / 16; rg += G * 4) { f32x4 acc[2];
                  pg8::skinny_gemm<2>(xb, (const bf16_t*)(ws + WS_WIN0), 1024 + 16 * hf, 32, rg, lane, 0, 2048, acc);
                  const int row = rg * 16 + fr, j0 = 16 * hf + 4 * fq;
                  const f32x4 cs0 = *(const f32x4*)(tab + ((size_t)row * 32 + j0) * 2), cs1 = *(const f32x4*)(tab + ((size_t)row * 32 + j0 + 2) * 2);
                  const f32x4 t1 = acc[0], t2 = acc[1]; u32x4 w;
                  w.x = cvtpk2(t1[0] * cs0[0] - t2[0] * cs0[1], t2[0] * cs0[0] + t1[0] * cs0[1]); w.y = cvtpk2(t1[1] * cs0[2] - t2[1] * cs0[3], t2[1] * cs0[2] + t1[1] * cs0[3]);
                  w.z = cvtpk2(t1[2] * cs1[0] - t2[2] * cs1[1], t2[2] * cs1[0] + t1[2] * cs1[1]); w.w = cvtpk2(t1[3] * cs1[2] - t2[3] * cs1[3], t2[3] * cs1[2] + t1[3] * cs1[3]);
                  *(u32x4*)(krope + (size_t)row * 64 + 2 * j0) = w; } }
            pg8::Gemm g_{xb, (const bf16_t*)(ws + WS_WIN0), M, 1024, 2048}; pg8::QuadOrder S_{bid};
            pg8::EpiRms E_{(bf16_t*)(ws + WS_CQN), (bf16_t*)(ws + WS_CKVN), a.in[3], a.in[5], (float*)(ws + WS_PART), bar};
            pg8::gemm_phase<pg8::EpiRms, pg8::QuadOrder, false, GSP2>(ldsl, g_, S_, E_, wid);
        } else { pg8::EpiF32 E{(float*)(ws + WS_H0), 1280}; GEMM(pg8::EpiF32, E, xb, ws + WS_WIN0, 1280, 2048); }
        SEAM(1); }
    if (IN(2) && !fusedLN) REPS(2) { LANE_TID; phase_mla_norm((const float*)(ws + WS_H0), (bf16_t*)(ws + WS_CQN), (bf16_t*)(ws + WS_CKVN), (bf16_t*)(ws + WS_KROPE), a.in[3], a.in[5], (const float*)(ws + WS_TAB), bid, G, wid, lane); SEAM(2);
#ifdef XSYNC
        for (int q_ = 0; q_ < XSYNC; ++q_) xcd_barrier(bar, (wid == 0) && (lane_opaque() == 0));
#endif
    }
    if (IN(3)) REPS(3) { { pg8::EpiQrope E{(bf16_t*)(ws + WS_Q), (const float*)(ws + WS_TAB)}; GEMM(pg8::EpiQrope, E, ws + WS_CQN, ws + WS_WQUP, 3072, 512); }
                 __syncthreads();
                 { pg8::EpiKV E{(bf16_t*)(ws + WS_K), (bf16_t*)(ws + WS_V)}; GEMM(pg8::EpiKV, E, ws + WS_CKVN, ws + WS_WKVUP, 4096, 512); } SEAM(3); }
    if (IN(4)) REPS(4) { att::attn_phase<192, false>((char*)lds, ldsl, (const att::bf16*)(ws + WS_Q), (const att::bf16*)(ws + WS_K), (const att::bf16*)(ws + WS_KROPE), (const att::bf16*)(ws + WS_V), (att::bf16*)(ws + WS_O), nullptr, G, bid, wid); SEAM(4); }
    if (IN(5)) REPS(5) { if (fusedLN) GEMM_LN(5, a.in[0], ws + WS_O, ws + WS_WO0, 2048, a.in[13], a.in[14]); else { pg8::EpiResid E{a.in[0], XR, DM, ALPHA}; GEMM(pg8::EpiResid, E, ws + WS_O, ws + WS_WO0, 2048, 2048); } SEAM(5); }
    if (IN(6) && !fusedLN) REPS(6) { LANE_TID; phase_ln(XR, xb, a.in[13], a.in[14], bid, G, wid, lane); SEAM(6); }
    if (IN(7)) REPS(7) { pg8::EpiSwiglu E{(bf16_t*)(ws + WS_HFF), FFH}; GEMM(pg8::EpiSwiglu, E, xb, ws + WS_WGU0, 11264, 2048); SEAM(7); }
    if (IN(8)) REPS(8) { if (fusedLN) GEMM_LN(8, XR, ws + WS_HFF, ws + WS_WDN0, 5632, a.in[15], a.in[16]); else { pg8::EpiResid E{XR, XR, DM, ALPHA}; GEMM(pg8::EpiResid, E, ws + WS_HFF, ws + WS_WDN0, 2048, 5632); } SEAM(8); }
    if (IN(9) && !fusedLN) REPS(9) { LANE_TID; phase_ln(XR, xb, a.in[15], a.in[16], bid, G, wid, lane); SEAM(9); }
    if (IN(10)) REPS(10) { { pg8::EpiFoxIn E{(bf16_t*)(ws + WS_FQ), (size_t)(WS_FK - WS_FQ) / 2, (float*)(ws + WS_LOGF), a.in[9]}; GEMM(pg8::EpiFoxIn, E, xb, ws + WS_WIN1, 6144, 2048); }
        { const int lane = lane_opaque(), fr = lane & 15, fq = lane >> 4, hf = wid & 1; LAS f32x4* xch = (LAS f32x4*)ldsl; float* lf = (float*)(ws + WS_LOGF); const f32x4 bb = *(const f32x4*)(a.in[9] + 4 * fq);
          for (int rg = bid * 4 + (wid >> 1); rg < M / 16; rg += G * 4) { f32x4 acc[1];
              pg8::skinny_gemm<1>(xb, (const bf16_t*)(ws + WS_WIN1), 6144, 0, rg, lane, hf * 1024, hf * 1024 + 1024, acc);
              __syncthreads();
              if (hf) xch[(wid >> 1) * 64 + lane] = acc[0];
              __syncthreads();
              if (!hf) { const f32x4 x = acc[0] + xch[(wid >> 1) * 64 + lane] + bb; f32x4 o; o[0] = pg8::lsig(x[0]); o[1] = pg8::lsig(x[1]); o[2] = pg8::lsig(x[2]); o[3] = pg8::lsig(x[3]);
                  *(f32x4*)(lf + (size_t)(rg * 16 + fr) * 16 + 4 * fq) = o; } } }
        SEAM(10); }
    if (IN(11)) REPS(11) { att::attn_phase<128, true>((char*)lds, ldsl, (const att::bf16*)(ws + WS_FQ), (const att::bf16*)(ws + WS_FK), nullptr, (const att::bf16*)(ws + WS_FV), (att::bf16*)(ws + WS_O), (const float*)(ws + WS_LOGF), G, bid, wid); SEAM(11); }
    if (IN(12)) REPS(12) { if (fusedLN) GEMM_LN(12, XR, ws + WS_O, ws + WS_WO1, 2048, a.in[13] + DM, a.in[14] + DM); else { pg8::EpiResid E{XR, XR, DM, ALPHA}; GEMM(pg8::EpiResid, E, ws + WS_O, ws + WS_WO1, 2048, 2048); } SEAM(12); }
    if (IN(13) && !fusedLN) REPS(13) { LANE_TID; phase_ln(XR, xb, a.in[13] + DM, a.in[14] + DM, bid, G, wid, lane); SEAM(13); }
    if (IN(14)) REPS(14) { pg8::EpiSwiglu E{(bf16_t*)(ws + WS_HFF), FFH}; GEMM(pg8::EpiSwiglu, E, xb, ws + WS_WGU1, 11264, 2048); SEAM(14); }
    if (IN(15)) REPS(15) { if (fusedLN) GEMM_LN(15, XR, ws + WS_HFF, ws + WS_WDN1, 5632, a.in[15] + DM, a.in[16] + DM); else { pg8::EpiResid E{XR, XR, DM, ALPHA}; GEMM(pg8::EpiResid, E, ws + WS_HFF, ws + WS_WDN1, 2048, 5632); SEAM(15); } }
    if (IN(16) && !fusedLN) REPS(16) { LANE_TID; phase_ln(XR, xb, a.in[15] + DM, a.in[16] + DM, bid, G, wid, lane); }
#undef IN
#undef SEAM
#undef GEMM
#undef GEMM_LN
}

extern "C" void kernel_launch(void* const* d_in, const int* in_sizes, int n_in, void* d_out, int out_size, void* d_ws, size_t ws_size, hipStream_t stream) {
    static int grid = 0;
    if (grid == 0) {
        int dev = 0, cus = 0, per_cu = 0;
        (void)hipGetDevice(&dev); (void)hipDeviceGetAttribute(&cus, hipDeviceAttributeMultiprocessorCount, dev);
        if (hipFuncSetAttribute((const void*)mega_fwd, hipFuncAttributeMaxDynamicSharedMemorySize, LDS_BYTES) != hipSuccess) fprintf(stderr, "kernel_launch: hipFuncSetAttribute failed\n");
        if (hipOccupancyMaxActiveBlocksPerMultiprocessor(&per_cu, (const void*)mega_fwd, 512, LDS_BYTES) != hipSuccess || per_cu < 1) { fprintf(stderr, "kernel_launch: occupancy query says %d\n", per_cu); per_cu = 1; }
        (void)hipGetLastError();
        if (cus <= 0) cus = 256;
        grid = cus * per_cu;
        if (n_in != 17 || ws_size < 600 * MiB) fprintf(stderr, "kernel_launch: unexpected n_in %d / ws %zu\n", n_in, ws_size);
    }
    Args a{};
    for (int i = 0; i < 17; ++i) a.in[i] = (const float*)d_in[i];
    a.pos = (const int*)d_in[1]; a.out = (float*)d_out; a.ws = (unsigned char*)d_ws;
#if ONE_LAUNCH
    a.ph_lo = 0; a.ph_hi = NPH; { void* args[] = {&a}; hipError_t e = hipLaunchCooperativeKernel((const void*)mega_fwd, dim3(grid), dim3(512), args, LDS_BYTES, stream);
      if (e != hipSuccess) fprintf(stderr, "cooperative launch failed: %s (grid %d)\n", hipGetErrorString(e), grid); }
#else
    for (int k = 0; k < NPH; ++k) { a.ph_lo = k; a.ph_hi = k + 1; void* args[] = {&a}; hipError_t e = hipLaunchCooperativeKernel((const void*)mega_fwd, dim3(grid), dim3(512), args, LDS_BYTES, stream);
      if (e != hipSuccess) { fprintf(stderr, "cooperative launch %d failed: %s (grid %d)\n", k, hipGetErrorString(e), grid); break; } }
#endif
}
```

```cpp
#include <hip/hip_runtime.h>
#include <hip/hip_cooperative_groups.h>
#include <hip/hip_bf16.h>
#include <cstdio>
#include <cstdint>
namespace cg = cooperative_groups;
#ifndef ONE_LAUNCH
#define ONE_LAUNCH 1
#endif
__device__ __forceinline__ int lane_opaque() { int l; asm volatile("v_mbcnt_lo_u32_b32 %0, -1, 0\n\tv_mbcnt_hi_u32_b32 %0, -1, %0" : "=v"(l)); return l; }
#define LAS __attribute__((address_space(3)))
#define XB_TMO      128
#define XB_XCNT(j)  (256  + 64 * (j))
#define XB_XSUB(j)  (1280 + 64 * (j))
#define XB_XGEN(j)  (2304 + 64 * (j))
#define XB_TOP      3328
#define XB_TOPGEN   3392
#define XCD_BAR_WORDS 3456
#define XB_SPIN_CAP (1u << 18)

__device__ __forceinline__ unsigned xb_ld(unsigned* p)              { return __hip_atomic_load(p, __ATOMIC_RELAXED, __HIP_MEMORY_SCOPE_AGENT); }
__device__ __forceinline__ unsigned xb_add(unsigned* p, unsigned v) { return __hip_atomic_fetch_add(p, v, __ATOMIC_RELAXED, __HIP_MEMORY_SCOPE_AGENT); }
__device__ __forceinline__ unsigned xb_xcc_id() { return (unsigned)__builtin_amdgcn_s_getreg((3 << 11) | 20) & 0xFu; }
#define XB_SPIN(cond, bar) do { unsigned _sp = 0; while (cond) { __builtin_amdgcn_s_sleep(1); \
    if ((++_sp & 255u) == 0u) { if (xb_ld(&(bar)[XB_TMO])) break; if (_sp > XB_SPIN_CAP) { atomicAdd(&(bar)[XB_TMO], 1u); break; } } } } while (0)

struct XcdBarrier {
    unsigned* bar; unsigned x;
    volatile LAS unsigned* st;
};

__device__ __forceinline__ XcdBarrier xcd_barrier_post(unsigned* bar, volatile LAS unsigned* st, const bool t0) {
    XcdBarrier b; b.bar = bar; b.x = xb_xcc_id(); b.st = st;
    if (t0) (void)xb_add(&bar[XB_XCNT(b.x)], 1u);
    return b;
}
__device__ __forceinline__ void xcd_barrier_complete(unsigned* bar, unsigned x, unsigned& nloc, unsigned& nx) {
    const unsigned G = gridDim.x * gridDim.y * gridDim.z;
    unsigned sum, cnt, mine, sp = 0u;
    for (;;) {
        sum = 0u; cnt = 0u; mine = 0u;
#pragma unroll
        for (unsigned j = 0; j < 16; ++j) { const unsigned c = xb_ld(&bar[XB_XCNT(j)]); sum += c; cnt += (c > 0u) ? 1u : 0u; mine = (j == x) ? c : mine; }
        if (sum == G) break;
        __builtin_amdgcn_s_sleep(1);
        if ((++sp & 255u) == 0u) { if (xb_ld(&bar[XB_TMO])) break; if (sp > XB_SPIN_CAP) { atomicAdd(&bar[XB_TMO], 1u); break; } }
    }
    nloc = mine > 0u ? mine : 1u; nx = cnt > 0u ? cnt : 1u;
}

__device__ __forceinline__ void xcd_barrier(const XcdBarrier& b, const bool t0) {
    asm volatile("s_waitcnt vmcnt(0)" ::: "memory");
    __syncthreads();
    if (t0) {
        unsigned* bar = b.bar;
        __builtin_amdgcn_s_waitcnt(0);
        unsigned nloc = b.st[0], nx = b.st[1];
        if (nloc == 0u) { xcd_barrier_complete(bar, b.x, nloc, nx); b.st[0] = nloc; b.st[1] = nx; }
        const unsigned old = xb_add(&bar[XB_XSUB(b.x)], 1u);
        const unsigned gen = old / nloc;
        if (old + 1u == (gen + 1u) * nloc) {
            __builtin_amdgcn_fence(__ATOMIC_RELEASE, "agent");
            asm volatile("s_waitcnt vmcnt(0)" ::: "memory");
            const unsigned og = xb_add(&bar[XB_TOP], 1u);
            const unsigned tg = og / nx;
            if (og + 1u == (tg + 1u) * nx) xb_add(&bar[XB_TOPGEN], 1u);
            else XB_SPIN(xb_ld(&bar[XB_TOPGEN]) == tg, bar);
            __builtin_amdgcn_fence(__ATOMIC_ACQUIRE, "agent");
            xb_add(&bar[XB_XGEN(b.x)], 1u);
            asm volatile("s_waitcnt vmcnt(0)" ::: "memory");
        } else {
            XB_SPIN(xb_ld(&bar[XB_XGEN(b.x)]) == gen, bar);
            __builtin_amdgcn_fence(__ATOMIC_ACQUIRE, "agent");
            asm volatile("s_waitcnt vmcnt(0)" ::: "memory");
        }
    }
    __syncthreads();
}
namespace pg8 {
#define PG8_LAS __attribute__((address_space(3)))
typedef unsigned short bf16_t;
typedef short bf16x8 __attribute__((ext_vector_type(8)));
typedef float f32x4 __attribute__((ext_vector_type(4)));
typedef unsigned u32x4 __attribute__((ext_vector_type(4)));
constexpr int BM = 256, BK = 64, HALF = 128, HTB = HALF * BK * 2  , STAGE_BYTES = 8 * HTB, NXCD = 8, WGM = 8;

__host__ __device__ __forceinline__ int lds_byte(int r, int c) { const int st = (r >> 4) * 2 + (c >> 5), rr = r & 15, cc = c & 31, ob = rr * 64 + cc * 2; return st * 1024 + (ob ^ (((ob >> 9) & 1) << 5)); }
__host__ __device__ __forceinline__ void stage_rc(int b, int& R, int& C) { const int st = b / 1024, sb = b % 1024, swz = sb ^ (((sb >> 9) & 1) << 5); R = (st >> 1) * 16 + swz / 64; C = (st & 1) * 32 + (swz % 64) / 2; }
__host__ __device__ __forceinline__ int perm32(int rho) { const int n = rho >> 4, i = rho & 15; return 8 * (i >> 2) + 4 * n + (i & 3); }

struct Unit { int pm, pn; };
struct Gemm { const bf16_t* A; const bf16_t* Bt; int M, N, K; };

struct StaticOrder {
    int nM, nN, nwg, G, c;
    __host__ __device__ void init(int M, int N, int G_, int c_) { nM = M / BM; nN = N / BM; nwg = nM * nN; G = G_; c = c_; }
    __host__ __device__ bool next(int i, Unit& u) const {
        const long L = (long)i * G + c; if (L >= nwg) return false;
        int wgid = (int)L; { const int q = nwg / NXCD, r = nwg % NXCD, xcd = wgid % NXCD, off = wgid / NXCD; wgid = (xcd < r ? xcd * (q + 1) : r * (q + 1) + (xcd - r) * q) + off; }
        const int nig = WGM * nN, gid = wgid / nig, fm = gid * WGM, gsz = (nM - fm) < WGM ? (nM - fm) : WGM;
        u.pm = fm + ((wgid % nig) % gsz); u.pn = (wgid % nig) / gsz; return true;
    }
    __device__ __forceinline__ void a_ready(const Unit&) const {}
    __device__ __forceinline__ void done(const Unit&) const {}
};

__device__ __forceinline__ unsigned cvt_pk_bf16(float lo, float hi) { unsigned r; asm volatile("v_cvt_pk_bf16_f32 %0, %1, %2" : "=v"(r) : "v"(lo), "v"(hi)); return r; }
typedef float f32x2 __attribute__((ext_vector_type(2)));
typedef unsigned u32x2 __attribute__((ext_vector_type(2)));
struct EpiF32 {
    static constexpr bool PERM = false, AFTER_DRAIN = false;
    float* O; int ldc;
    __device__ __forceinline__ void operator()(const f32x4 (&acc)[2][2][4][2], const Unit& u, int wr, int wc, int fr, int fq) const {
        const int row0 = u.pm * BM + wr * 64 + fr, col0 = u.pn * BM + wc * 32 + 4 * fq;
#pragma unroll
        for (int ai = 0; ai < 2; ++ai)
#pragma unroll
            for (int m = 0; m < 4; ++m) { float* rowp = O + (size_t)(row0 + ai * HALF + m * 16) * ldc + col0;
#pragma unroll
                for (int bj = 0; bj < 2; ++bj)
#pragma unroll
                    for (int n = 0; n < 2; ++n) *(f32x4*)(rowp + bj * HALF + n * 16) = acc[ai][bj][m][n]; }
    }
};
struct EpiResid {
    static constexpr bool PERM = false, AFTER_DRAIN = false;
    const float* base; float* out; int ldc; float alpha;
    __device__ __forceinline__ void operator()(const f32x4 (&acc)[2][2][4][2], const Unit& u, int wr, int wc, int fr, int fq) const {
        const int row0 = u.pm * BM + wr * 64 + fr, col0 = u.pn * BM + wc * 32 + 4 * fq;
#pragma unroll
        for (int ai = 0; ai < 2; ++ai)
#pragma unroll
            for (int m = 0; m < 4; ++m) { const size_t off = (size_t)(row0 + ai * HALF + m * 16) * ldc + col0;
                f32x4 b[2][2];
#pragma unroll
                for (int bj = 0; bj < 2; ++bj)
#pragma unroll
                    for (int n = 0; n < 2; ++n) b[bj][n] = *(const f32x4*)(base + off + bj * HALF + n * 16);
#pragma unroll
                for (int bj = 0; bj < 2; ++bj)
#pragma unroll
                    for (int n = 0; n < 2; ++n) *(f32x4*)(out + off + bj * HALF + n * 16) = b[bj][n] * alpha + acc[ai][bj][m][n]; }
    }
};
__device__ __forceinline__ float silu_mul(float g, float u) { return g * __builtin_amdgcn_rcpf(1.0f + __builtin_amdgcn_exp2f(-1.4426950408889634f * g)) * u; }
struct EpiSwiglu {
    static constexpr bool PERM = true, AFTER_DRAIN = false;
    bf16_t* O; int ldc;
    __device__ __forceinline__ void operator()(const f32x4 (&acc)[2][2][4][2], const Unit& u, int wr, int wc, int fr, int fq) const {
        const int row0 = u.pm * BM + wr * 64 + fr, col0 = u.pn * HALF + wc * 32 + 8 * fq;
#pragma unroll
        for (int ai = 0; ai < 2; ++ai)
#pragma unroll
            for (int m = 0; m < 4; ++m) { bf16_t* rowp = O + (size_t)(row0 + ai * HALF + m * 16) * ldc + col0;
                const f32x4 g0 = acc[ai][0][m][0], g1 = acc[ai][0][m][1], u0 = acc[ai][1][m][0], u1 = acc[ai][1][m][1];
                u32x4 w; w.x = cvt_pk_bf16(silu_mul(g0[0], u0[0]), silu_mul(g0[1], u0[1])); w.y = cvt_pk_bf16(silu_mul(g0[2], u0[2]), silu_mul(g0[3], u0[3]));
                w.z = cvt_pk_bf16(silu_mul(g1[0], u1[0]), silu_mul(g1[1], u1[1])); w.w = cvt_pk_bf16(silu_mul(g1[2], u1[2]), silu_mul(g1[3], u1[3]));
#ifdef XNT
                __builtin_nontemporal_store(w, (u32x4*)rowp); }
#else
                *(u32x4*)rowp = w; }
#endif
    }
};
__device__ __forceinline__ u32x4 pack8bf(const f32x4 v0, const f32x4 v1) { u32x4 w; w.x = cvt_pk_bf16(v0[0], v0[1]); w.y = cvt_pk_bf16(v0[2], v0[3]); w.z = cvt_pk_bf16(v1[0], v1[1]); w.w = cvt_pk_bf16(v1[2], v1[3]); return w; }
struct EpiKV {
    static constexpr bool PERM = true, AFTER_DRAIN = false;
    bf16_t* Kb; bf16_t* Vb;
    __device__ __forceinline__ void operator()(const f32x4 (&acc)[2][2][4][2], const Unit& u, int wr, int wc, int fr, int fq) const {
        const int row0 = u.pm * BM + wr * 64 + fr, col0 = u.pn * HALF + wc * 32 + 8 * fq;
#pragma unroll
        for (int ai = 0; ai < 2; ++ai)
#pragma unroll
            for (int m = 0; m < 4; ++m) { const size_t off = (size_t)(row0 + ai * HALF + m * 16) * 2048 + col0;
                *(u32x4*)(Kb + off) = pack8bf(acc[ai][0][m][0], acc[ai][0][m][1]);
                *(u32x4*)(Vb + off) = pack8bf(acc[ai][1][m][0], acc[ai][1][m][1]); }
    }
};
struct EpiQrope {
    static constexpr bool PERM = true, AFTER_DRAIN = false;
    bf16_t* O; const float* tab;
    __device__ __forceinline__ void operator()(const f32x4 (&acc)[2][2][4][2], const Unit& u, int wr, int wc, int fr, int fq) const {
        const int row0 = u.pm * BM + wr * 64 + fr;
#pragma unroll
        for (int bj = 0; bj < 2; ++bj) {
            const int col0 = u.pn * BM + bj * HALF + wc * 32 + 8 * fq; const int w = col0 % 192; const bool rope = w >= 128; const int j0 = (w - 128) >> 1;
#pragma unroll
            for (int ai = 0; ai < 2; ++ai)
#pragma unroll
                for (int m = 0; m < 4; ++m) { const int row = row0 + ai * HALF + m * 16;
                    f32x4 v0 = acc[ai][bj][m][0], v1 = acc[ai][bj][m][1];
                    if (rope) { const f32x4 cs0 = *(const f32x4*)(tab + ((size_t)row * 32 + j0) * 2), cs1 = *(const f32x4*)(tab + ((size_t)row * 32 + j0 + 2) * 2);
                        f32x4 r0, r1;
                        r0[0] = v0[0] * cs0[0] - v0[1] * cs0[1]; r0[1] = v0[1] * cs0[0] + v0[0] * cs0[1];
                        r0[2] = v0[2] * cs0[2] - v0[3] * cs0[3]; r0[3] = v0[3] * cs0[2] + v0[2] * cs0[3];
                        r1[0] = v1[0] * cs1[0] - v1[1] * cs1[1]; r1[1] = v1[1] * cs1[0] + v1[0] * cs1[1];
                        r1[2] = v1[2] * cs1[2] - v1[3] * cs1[3]; r1[3] = v1[3] * cs1[2] + v1[2] * cs1[3];
                        v0 = r0; v1 = r1; }
                    *(u32x4*)(O + (size_t)row * 3072 + col0) = pack8bf(v0, v1); }
        }
    }
};
__device__ __forceinline__ float lsig(float x) { return fminf(x, 0.f) - 0.6931471805599453f * __builtin_amdgcn_logf(1.0f + __builtin_amdgcn_exp2f(-1.4426950408889634f * fabsf(x))); }
struct EpiFoxIn {
    static constexpr bool PERM = true, AFTER_DRAIN = false;
    bf16_t* QKV; size_t stride; float* logf; const float* bf;
    __device__ __forceinline__ void operator()(const f32x4 (&acc)[2][2][4][2], const Unit& u, int wr, int wc, int fr, int fq) const {
        const int row0 = u.pm * BM + wr * 64 + fr;
        if (u.pn < 24) {
            bf16_t* base = QKV + (size_t)(u.pn >> 3) * stride; const int colt = (u.pn & 7) * BM + wc * 32 + 8 * fq;
#pragma unroll
            for (int ai = 0; ai < 2; ++ai)
#pragma unroll
                for (int m = 0; m < 4; ++m) { bf16_t* rowp = base + (size_t)(row0 + ai * HALF + m * 16) * 2048 + colt;
#pragma unroll
                    for (int bj = 0; bj < 2; ++bj) *(u32x4*)(rowp + bj * HALF) = pack8bf(acc[ai][bj][m][0], acc[ai][bj][m][1]); }
        } else if (wc == 0 && fq < 2) {
#pragma unroll
            for (int ai = 0; ai < 2; ++ai)
#pragma unroll
                for (int m = 0; m < 4; ++m) { const int row = row0 + ai * HALF + m * 16;
#pragma unroll
                    for (int n = 0; n < 2; ++n) { const int c = 8 * fq + 4 * n; const f32x4 bb = *(const f32x4*)(bf + c); const f32x4 x = acc[ai][0][m][n] + bb; f32x4 o;
                        o[0] = lsig(x[0]); o[1] = lsig(x[1]); o[2] = lsig(x[2]); o[3] = lsig(x[3]);
                        *(f32x4*)(logf + (size_t)row * 16 + c) = o; } }
        }
    }
};

struct EpiResidLN {
    static constexpr bool PERM = false, AFTER_DRAIN = true;
    const float* base; float* out; bf16_t* xb; const float* g; const float* bt; float* part  ; XcdBarrier bar; float alpha; float accs;
    __device__ __forceinline__ void fused(f32x4 (&acc)[2][2][4][2], const Unit& u, int wr, int wc, int fr, int fq, PG8_LAS unsigned char* lds, int wid, int lane) const {
        PG8_LAS f32x2* P = (PG8_LAS f32x2*)lds;
        PG8_LAS f32x2* S = (PG8_LAS f32x2*)(lds + 8192);
        const int col0 = u.pn * BM + wc * 32 + 4 * fq;
#pragma unroll
        for (int ai = 0; ai < 2; ++ai)
#pragma unroll
            for (int m = 0; m < 4; ++m) { const size_t off = (size_t)(u.pm * BM + ai * HALF + wr * 64 + m * 16 + fr) * 2048 + col0;
                float s = 0.f, q = 0.f;
#pragma unroll
                for (int bj = 0; bj < 2; ++bj)
#pragma unroll
                    for (int n = 0; n < 2; ++n) { const f32x4 b = *(const f32x4*)(base + off + bj * HALF + n * 16); const f32x4 v = b * alpha + acc[ai][bj][m][n] * accs; acc[ai][bj][m][n] = v;
                        s += (v[0] + v[1]) + (v[2] + v[3]); q += (v[0] * v[0] + v[1] * v[1]) + (v[2] * v[2] + v[3] * v[3]); }
                s += __shfl_xor(s, 16); s += __shfl_xor(s, 32); q += __shfl_xor(q, 16); q += __shfl_xor(q, 32);
                if (fq == 0) P[(ai * HALF + wr * 64 + m * 16 + fr) * 4 + wc] = (f32x2){s, q};
                if (m & 1) asm volatile("" ::: "memory"); }
        asm volatile("s_waitcnt lgkmcnt(0)" ::: "memory"); __builtin_amdgcn_s_barrier(); asm volatile("" ::: "memory");
        const int tid = wid * 64 + lane;
        if (tid < 256) { const f32x2 a = P[tid * 4 + 0], b = P[tid * 4 + 1], c = P[tid * 4 + 2], d = P[tid * 4 + 3];
            const float s = (a.x + b.x) + (c.x + d.x), q = (a.y + b.y) + (c.y + d.y);
            unsigned long long* slot = (unsigned long long*)part + ((size_t)(u.pm * BM + tid) * 8 + u.pn);
            __hip_atomic_store(slot, ((unsigned long long)__float_as_uint(q) << 32) | __float_as_uint(s), __ATOMIC_RELAXED, __HIP_MEMORY_SCOPE_AGENT); }
        xcd_barrier(bar, tid == 0);
        if (tid < 256) { const unsigned long long* slot = (const unsigned long long*)part + (size_t)(u.pm * BM + tid) * 8; float s = 0.f, q = 0.f;
#pragma unroll
            for (int t = 0; t < 8; ++t) { const unsigned long long w = __hip_atomic_load(slot + t, __ATOMIC_RELAXED, __HIP_MEMORY_SCOPE_AGENT); s += __uint_as_float((unsigned)w); q += __uint_as_float((unsigned)(w >> 32)); }
            const float mean = s * (1.f / 2048.f), var = fmaxf(q * (1.f / 2048.f) - mean * mean, 0.f);
            S[tid] = (f32x2){mean, 1.0f / sqrtf(var + 1e-5f)}; }
        asm volatile("s_waitcnt lgkmcnt(0)" ::: "memory"); __builtin_amdgcn_s_barrier(); asm volatile("" ::: "memory");
        f32x4 gg[2][2], bb[2][2];
#pragma unroll
        for (int bj = 0; bj < 2; ++bj)
#pragma unroll
            for (int n = 0; n < 2; ++n) { gg[bj][n] = *(const f32x4*)(g + col0 + bj * HALF + n * 16); bb[bj][n] = *(const f32x4*)(bt + col0 + bj * HALF + n * 16); }
#pragma unroll
        for (int ai = 0; ai < 2; ++ai)
#pragma unroll
            for (int m = 0; m < 4; ++m) { const int r = ai * HALF + wr * 64 + m * 16 + fr; const f32x2 sr = S[r]; const size_t off = (size_t)(u.pm * BM + r) * 2048 + col0;
#pragma unroll
                for (int bj = 0; bj < 2; ++bj)
#pragma unroll
                    for (int n = 0; n < 2; ++n) { const f32x4 o = (acc[ai][bj][m][n] - sr.x) * sr.y * gg[bj][n] + bb[bj][n];
                        *(f32x4*)(out + off + bj * HALF + n * 16) = o; if (xb) { u32x2 w; w.x = cvt_pk_bf16(o[0], o[1]); w.y = cvt_pk_bf16(o[2], o[3]); *(u32x2*)(xb + off + bj * HALF + n * 16) = w; } } }
    }
};
struct PanelRound {
    int r, c;
    __device__ bool next(int i, Unit& u) const { if (i != 0) return false; const int x = c & 7, j = c >> 3; u.pm = r * 32 + x * 4 + (j & 3); u.pn = j >> 2; return true; }
    __device__ __forceinline__ void a_ready(const Unit&) const {}
    __device__ __forceinline__ void done(const Unit&) const {}
};

struct EpiRms {
    static constexpr bool PERM = true, AFTER_DRAIN = true;
    bf16_t* cqn; bf16_t* ckvn; const float* gq; const float* gkv; float* part  ; XcdBarrier bar;
    __device__ __forceinline__ void fused(f32x4 (&acc)[2][2][4][2], const Unit& u, int wr, int wc, int fr, int fq, PG8_LAS unsigned char* lds, int wid, int lane) const {
        PG8_LAS float* P = (PG8_LAS float*)lds;
        PG8_LAS float* S = (PG8_LAS float*)(lds + 4096);
#pragma unroll
        for (int ai = 0; ai < 2; ++ai)
#pragma unroll
            for (int m = 0; m < 4; ++m) { float q = 0.f;
#pragma unroll
                for (int bj = 0; bj < 2; ++bj)
#pragma unroll
                    for (int n = 0; n < 2; ++n) { const f32x4 v = acc[ai][bj][m][n]; q += (v[0] * v[0] + v[1] * v[1]) + (v[2] * v[2] + v[3] * v[3]); }
                q += __shfl_xor(q, 16); q += __shfl_xor(q, 32);
                if (fq == 0) P[(ai * HALF + wr * 64 + m * 16 + fr) * 4 + wc] = q; }
        asm volatile("s_waitcnt lgkmcnt(0)" ::: "memory"); __builtin_amdgcn_s_barrier(); asm volatile("" ::: "memory");
        const int tid = wid * 64 + lane;
        if (tid < 256) { const float q = (P[tid * 4 + 0] + P[tid * 4 + 1]) + (P[tid * 4 + 2] + P[tid * 4 + 3]);
            unsigned long long* slot = (unsigned long long*)part + ((size_t)(u.pm * BM + tid) * 8 + u.pn);
            __hip_atomic_store(slot, (unsigned long long)__float_as_uint(q), __ATOMIC_RELAXED, __HIP_MEMORY_SCOPE_AGENT); }
        xcd_barrier(bar, tid == 0);
        if (tid < 256) { const unsigned long long* slot = (const unsigned long long*)part + (size_t)(u.pm * BM + tid) * 8 + (u.pn & 2);
            const float q = __uint_as_float((unsigned)__hip_atomic_load(slot, __ATOMIC_RELAXED, __HIP_MEMORY_SCOPE_AGENT)) + __uint_as_float((unsigned)__hip_atomic_load(slot + 1, __ATOMIC_RELAXED, __HIP_MEMORY_SCOPE_AGENT));
            S[tid] = 1.0f / sqrtf(q * (1.f / 512.f) + 1e-6f); }
        asm volatile("s_waitcnt lgkmcnt(0)" ::: "memory"); __builtin_amdgcn_s_barrier(); asm volatile("" ::: "memory");
        bf16_t* O = (u.pn & 2) ? ckvn : cqn; const float* g = (u.pn & 2) ? gkv : gq;
        const int colp = (u.pn & 1) * BM + wc * 32 + 8 * fq;
        f32x4 gg[2][2];
#pragma unroll
        for (int bj = 0; bj < 2; ++bj)
#pragma unroll
            for (int n = 0; n < 2; ++n) gg[bj][n] = *(const f32x4*)(g + colp + bj * HALF + 4 * n);
#pragma unroll
        for (int ai = 0; ai < 2; ++ai)
#pragma unroll
            for (int m = 0; m < 4; ++m) { const int r = ai * HALF + wr * 64 + m * 16 + fr; const float rs = S[r]; bf16_t* rowp = O + (size_t)(u.pm * BM + r) * 512 + colp;
#pragma unroll
                for (int bj = 0; bj < 2; ++bj) *(u32x4*)(rowp + bj * HALF) = pack8bf(acc[ai][bj][m][0] * rs * gg[bj][0], acc[ai][bj][m][1] * rs * gg[bj][1]); }
    }
};
struct QuadOrder {
    int c;
    __device__ bool next(int i, Unit& u) const { if (i != 0) return false; const int x = c & 7, j = c >> 3; u.pm = x * 8 + (j & 7); u.pn = j >> 3; return true; }
    __device__ __forceinline__ void a_ready(const Unit&) const {}
    __device__ __forceinline__ void done(const Unit&) const {}
};
template <int NT>
__device__ __forceinline__ void skinny_gemm(const bf16_t* __restrict__ X, const bf16_t* __restrict__ Wt, int wrow0, int wstride, int rg, int lane, int k_lo, int k_hi, f32x4 (&acc)[NT]) {
    const int fr = lane & 15, fq = lane >> 4;
    const bf16_t* xa = X + (size_t)(rg * 16 + fr) * 2048 + 8 * fq;
    const bf16_t* wb = Wt + (size_t)(wrow0 + fr) * 2048 + 8 * fq;
#pragma unroll
    for (int nt = 0; nt < NT; ++nt) acc[nt] = (f32x4){0.f, 0.f, 0.f, 0.f};
    bf16x8 a0[4], b0[NT][4], a1[4], b1[NT][4];
#define SK_LOAD(A_, B_, k_) do { _Pragma("unroll") for (int u_ = 0; u_ < 4; ++u_) { A_[u_] = *(const bf16x8*)(xa + (k_) + 32 * u_); \
        _Pragma("unroll") for (int nt = 0; nt < NT; ++nt) B_[nt][u_] = *(const bf16x8*)(wb + (size_t)nt * wstride * 2048 + (k_) + 32 * u_); } } while (0)
#define SK_MMA(A_, B_) do { _Pragma("unroll") for (int u_ = 0; u_ < 4; ++u_) _Pragma("unroll") for (int nt = 0; nt < NT; ++nt) \
        acc[nt] = __builtin_amdgcn_mfma_f32_16x16x32_bf16(B_[nt][u_], A_[u_], acc[nt], 0, 0, 0); } while (0)
    SK_LOAD(a0, b0, k_lo);
    for (int k = k_lo; k < k_hi; k += 256) {
        SK_LOAD(a1, b1, k + 128);
        SK_MMA(a0, b0);
        if (k + 256 < k_hi) SK_LOAD(a0, b0, k + 256);
        SK_MMA(a1, b1);
    }
#undef SK_LOAD
#undef SK_MMA
}
template <class Epi, class Sched, bool ALIGN_EPI = false, bool SP2 = false>
__device__ __forceinline__ void gemm_phase(PG8_LAS unsigned char* lds, const Gemm g, const Sched& S, const Epi& E, const int wid) {
    const int lane = lane_opaque(), tid = wid * 64 + lane, wr = wid >> 2, wc = wid & 3, fr = lane & 15, fq = lane >> 4;
    const int K = g.K, nt = K / BK;
    unsigned voffA[2], voffB[2];
#pragma unroll
    for (int i = 0; i < 2; ++i) { int R, C; stage_rc(tid * 16 + i * 8192, R, C); const int Rb = Epi::PERM ? ((R & ~31) + perm32(R & 31)) : R;
        voffA[i] = (unsigned)(R * K + C) * 2u; voffB[i] = (unsigned)(Rb * K + C) * 2u; }
    const size_t kstep = (size_t)(BK * 2);
    const size_t hstep = (size_t)HALF * K * 2;
    const size_t tstep = 2 * hstep;
    const unsigned ldsw = (unsigned)wid * 1024u;
    const int aoff = lds_byte(wr * 64 + fr, fq * 8), boff = lds_byte(wc * 32 + fr, fq * 8);
#define PG8_SA(b, h) (((b) * 2 + (h)) * HTB)
#define PG8_SB(b, h) ((4 + (b) * 2 + (h)) * HTB)
#define PG8_STAGE(bufoff, gbase, voff) do { _Pragma("unroll") for (int _i = 0; _i < 2; ++_i) \
        __builtin_amdgcn_global_load_lds((const unsigned*)((const char*)(gbase) + (voff)[_i]), (PG8_LAS unsigned*)(lds + (bufoff) + ldsw + _i * 8192), 16, 0, 0); } while (0)
#define PG8_LDA(dst, b, h) do { _Pragma("unroll") for (int m = 0; m < 4; ++m) _Pragma("unroll") for (int k = 0; k < 2; ++k) dst[m][k] = *(const PG8_LAS bf16x8*)(lds + PG8_SA(b, h) + aoff + m * 2048 + k * 1024); } while (0)
#define PG8_LDB(dst, b, h) do { _Pragma("unroll") for (int n = 0; n < 2; ++n) _Pragma("unroll") for (int k = 0; k < 2; ++k) dst[n][k] = *(const PG8_LAS bf16x8*)(lds + PG8_SB(b, h) + boff + n * 2048 + k * 1024); } while (0)
#define PG8_MMA(ai, bj, At, Bt) do { __builtin_amdgcn_s_setprio(1); _Pragma("unroll") for (int m = 0; m < 4; ++m) _Pragma("unroll") for (int n = 0; n < 2; ++n) _Pragma("unroll") for (int k = 0; k < 2; ++k) \
        acc[ai][bj][m][n] = __builtin_amdgcn_mfma_f32_16x16x32_bf16(Bt[n][k], At[m][k], acc[ai][bj][m][n], 0, 0, 0); __builtin_amdgcn_s_setprio(0); } while (0)
#define PG8_WAIT_V(n) asm volatile("s_waitcnt vmcnt(" #n ")" ::: "memory")
#define PG8_WAIT_L(n) asm volatile("s_waitcnt lgkmcnt(" #n ")" ::: "memory")
#define PG8_BAR __builtin_amdgcn_s_barrier()
#define PG8_SCHED __builtin_amdgcn_sched_barrier(0)
    Unit cur, nxt; int ui = 0;
    if (!S.next(0, cur)) return;
    f32x4 acc[2][2][4][2];
#pragma unroll
    for (int a = 0; a < 2; ++a)
#pragma unroll
        for (int b = 0; b < 2; ++b)
#pragma unroll
            for (int m = 0; m < 4; ++m)
#pragma unroll
                for (int n = 0; n < 2; ++n) acc[a][b][m][n] = (f32x4){0.f, 0.f, 0.f, 0.f};
    bf16x8 At[4][2], B0[2][2], B1[2][2];
    const char* cA = (const char*)g.A + (size_t)cur.pm * tstep; const char* cB = (const char*)g.Bt + (size_t)cur.pn * tstep;
    S.a_ready(cur);
    if constexpr (SP2) {
        PG8_STAGE(PG8_SB(0, 0), cB, voffB); PG8_STAGE(PG8_SB(0, 1), cB + hstep, voffB); PG8_STAGE(PG8_SA(0, 0), cA, voffA); PG8_STAGE(PG8_SA(0, 1), cA + hstep, voffA);
        if (wr == 1) PG8_BAR;
        PG8_WAIT_V(2); PG8_BAR;
        PG8_STAGE(PG8_SB(1, 0), cB + kstep, voffB); PG8_STAGE(PG8_SA(1, 0), cA + kstep, voffA); PG8_STAGE(PG8_SB(1, 1), cB + hstep + kstep, voffB);
        PG8_WAIT_V(6); PG8_BAR;
    } else {
        PG8_STAGE(PG8_SB(0, 0), cB, voffB); PG8_STAGE(PG8_SA(0, 0), cA, voffA); PG8_STAGE(PG8_SB(0, 1), cB + hstep, voffB); PG8_STAGE(PG8_SA(0, 1), cA + hstep, voffA);
        if (wr == 1) PG8_BAR;
        PG8_WAIT_V(4); PG8_BAR;
        PG8_STAGE(PG8_SB(1, 0), cB + kstep, voffB); PG8_STAGE(PG8_SA(1, 0), cA + kstep, voffA); PG8_STAGE(PG8_SB(1, 1), cB + hstep + kstep, voffB);
        PG8_WAIT_V(6); PG8_BAR;
    }
    for (;;) {
        const bool has_next = S.next(ui + 1, nxt);
        const char* nA = has_next ? (const char*)g.A + (size_t)nxt.pm * tstep : cA; const char* nB = has_next ? (const char*)g.Bt + (size_t)nxt.pn * tstep : cB;
        for (int t = 0; t < nt; t += 2) {
            const bool last = (t == nt - 2);
            const char* a1 = cA + (size_t)(t + 1) * kstep;
            const char* a2 = last ? nA : cA + (size_t)(t + 2) * kstep; const char* b2 = last ? nB : cB + (size_t)(t + 2) * kstep;
            const char* a3 = a2 + kstep; const char* b3 = b2 + kstep;
            if (last && has_next) S.a_ready(nxt);
            if constexpr (SP2) {
            PG8_LDB(B0, 0, 0); PG8_LDB(B1, 0, 1); PG8_SCHED; PG8_LDA(At, 0, 0); PG8_STAGE(PG8_SA(1, 1), a1 + hstep, voffA);
            PG8_WAIT_V(8); PG8_WAIT_L(0); PG8_BAR; PG8_MMA(0, 0, At, B0); PG8_MMA(0, 1, At, B1); PG8_BAR; PG8_SCHED;
            PG8_LDA(At, 0, 1); PG8_STAGE(PG8_SB(0, 0), b2, voffB); PG8_STAGE(PG8_SB(0, 1), b2 + hstep, voffB); PG8_STAGE(PG8_SA(0, 0), a2, voffA);
            PG8_WAIT_V(8); PG8_WAIT_L(0); PG8_BAR; PG8_MMA(1, 0, At, B0); PG8_MMA(1, 1, At, B1); PG8_BAR; PG8_SCHED;
            PG8_LDB(B0, 1, 0); PG8_LDB(B1, 1, 1); PG8_SCHED; PG8_LDA(At, 1, 0); PG8_STAGE(PG8_SA(0, 1), a2 + hstep, voffA);
            PG8_WAIT_V(8); PG8_WAIT_L(0); PG8_BAR; PG8_MMA(0, 0, At, B0); PG8_MMA(0, 1, At, B1); PG8_BAR; PG8_SCHED;
            PG8_LDA(At, 1, 1); PG8_STAGE(PG8_SB(1, 0), b3, voffB); PG8_STAGE(PG8_SB(1, 1), b3 + hstep, voffB); PG8_STAGE(PG8_SA(1, 0), a3, voffA);
            PG8_WAIT_V(8); PG8_WAIT_L(0); PG8_BAR; PG8_MMA(1, 0, At, B0); PG8_MMA(1, 1, At, B1); PG8_BAR; PG8_SCHED;
            } else {
            PG8_LDB(B0, 0, 0); PG8_SCHED; PG8_LDA(At, 0, 0); PG8_STAGE(PG8_SA(1, 1), a1 + hstep, voffA);
            PG8_WAIT_L(8); PG8_BAR; PG8_WAIT_L(0); PG8_MMA(0, 0, At, B0); PG8_BAR; PG8_SCHED;
            PG8_LDB(B1, 0, 1); PG8_STAGE(PG8_SB(0, 0), b2, voffB);
            PG8_BAR; PG8_WAIT_L(0); PG8_MMA(0, 1, At, B1); PG8_BAR;
            PG8_LDA(At, 0, 1); PG8_STAGE(PG8_SA(0, 0), a2, voffA);
            PG8_BAR; PG8_WAIT_L(0); PG8_MMA(1, 0, At, B0); PG8_BAR; PG8_SCHED;
            PG8_STAGE(PG8_SB(0, 1), b2 + hstep, voffB);
            PG8_WAIT_V(6); PG8_BAR; PG8_MMA(1, 1, At, B1); PG8_BAR;
            PG8_LDB(B0, 1, 0); PG8_SCHED; PG8_LDA(At, 1, 0); PG8_STAGE(PG8_SA(0, 1), a2 + hstep, voffA);
            PG8_WAIT_L(8); PG8_BAR; PG8_WAIT_L(0); PG8_MMA(0, 0, At, B0); PG8_BAR; PG8_SCHED;
            PG8_LDB(B1, 1, 1); PG8_STAGE(PG8_SB(1, 0), b3, voffB);
            PG8_BAR; PG8_WAIT_L(0); PG8_MMA(0, 1, At, B1); PG8_BAR;
            PG8_LDA(At, 1, 1); PG8_STAGE(PG8_SA(1, 0), a3, voffA);
            PG8_BAR; PG8_WAIT_L(0); PG8_MMA(1, 0, At, B0); PG8_BAR; PG8_SCHED;
            PG8_STAGE(PG8_SB(1, 1), b3 + hstep, voffB);
            PG8_WAIT_V(6); PG8_BAR; PG8_MMA(1, 1, At, B1); PG8_BAR;
            }
        }
        if constexpr (ALIGN_EPI) { if (wr == 0) PG8_BAR; }
        if constexpr (!Epi::AFTER_DRAIN) { E(acc, cur, wr, wc, fr, fq);
#ifdef XEPI2
            for (int q_ = 0; q_ < XEPI2; ++q_) { asm volatile("" ::: "memory"); E(acc, cur, wr, wc, fr, fq); }
#endif
            S.done(cur); }
        if (!has_next) break;
#pragma unroll
        for (int a = 0; a < 2; ++a)
#pragma unroll
            for (int b = 0; b < 2; ++b)
#pragma unroll
                for (int m = 0; m < 4; ++m)
#pragma unroll
                    for (int n = 0; n < 2; ++n) acc[a][b][m][n] = (f32x4){0.f, 0.f, 0.f, 0.f};
        cur = nxt; cA = nA; cB = nB; ++ui;
        if constexpr (ALIGN_EPI) { if (wr == 1) PG8_BAR; }
    }
    PG8_WAIT_V(0);
    if constexpr (!ALIGN_EPI) { if (wr == 0) PG8_BAR; }
    PG8_BAR;
    if constexpr (Epi::AFTER_DRAIN) { E.fused(acc, cur, wr, wc, fr, fq, lds, wid, lane); S.done(cur); }
#undef PG8_SA
#undef PG8_SB
#undef PG8_STAGE
#undef PG8_LDA
#undef PG8_LDB
#undef PG8_MMA
#undef PG8_WAIT_V
#undef PG8_WAIT_L
#undef PG8_BAR
#undef PG8_SCHED
}
}
namespace att {
using bf16 = __hip_bfloat16;
typedef short bf16x8 __attribute__((ext_vector_type(8)));
typedef short s16x4 __attribute__((ext_vector_type(4)));
typedef float f32x16 __attribute__((ext_vector_type(16)));
typedef float f32x4 __attribute__((ext_vector_type(4)));
typedef unsigned u32x4 __attribute__((ext_vector_type(4)));
template <class A, class Bt> struct same_t { static constexpr bool v = false; };
template <class A> struct same_t<A, A> { static constexpr bool v = true; };

#define KSWZ(row, colB) ((row) * 256 + ((colB) ^ (((row) & 7) << 4)))
#define SBAR() __builtin_amdgcn_sched_barrier(0)
__device__ __forceinline__ int v_st(int k, int c) { const int kk = (k & ~0xC) | ((k & 4) << 1) | ((k & 8) >> 1); return ((kk >> 3) * 4 + (c >> 5)) * 512 + ((kk & 7) * 32 + (c & 31)) * 2; }
__device__ __forceinline__ int v_rd_base(int lane) { return ((lane & 3) << 3) | (((lane >> 2) & 3) << 6) | (((lane >> 4) & 1) << 5) | (((lane >> 5) & 1) << 8); }
constexpr int v_rd_off(int d0, int ks, int half) { return d0 * 512 + ks * 4096 + half * 2048; }
__device__ __forceinline__ int crow(int r, int hi) { return (r & 3) + 8 * (r >> 2) + 4 * hi; }
__device__ __forceinline__ unsigned cvtpk(float lo, float hi) {
    unsigned r; asm volatile("v_cvt_pk_bf16_f32 %0, %1, %2" : "=v"(r) : "v"(lo), "v"(hi)); return r;
}
__device__ __forceinline__ bf16x8 pack8(f32x4 a, f32x4 b) {
    u32x4 w = {cvtpk(a[0], a[1]), cvtpk(a[2], a[3]), cvtpk(b[0], b[1]), cvtpk(b[2], b[3])};
    return *reinterpret_cast<bf16x8*>(&w);
}
template <class T> __device__ __forceinline__ bf16x8 load8(const T* p) {
    if constexpr (same_t<T, float>::v) { return pack8(*(const f32x4*)p, *(const f32x4*)(p + 4)); }
    else { return *reinterpret_cast<const bf16x8*>(p); }
}
__device__ __forceinline__ void mask_tile(f32x16& p0, f32x16& p1, int dq, unsigned W) {
    const float NEG = -__builtin_inff();
#pragma unroll
    for (int r = 0; r < 16; ++r) {
        const int c = (r & 3) + 8 * (r >> 2);
        if ((unsigned)(dq - c) >= W) p0[r] = NEG;
        if ((unsigned)(dq - c - 32) >= W) p1[r] = NEG;
    }
}
constexpr int SHM_V = 16384;
template <int DQK> struct ACfg { static constexpr float SCALE = DQK == 192 ? 0.07216878364870323f : 0.08838834764831845f; };
constexpr float THR = 8.f;
template <int DQK>
__device__ __forceinline__ void partialSM(f32x16& p0, f32x16& p1, float& m_reg, float& mn, float& alpha) {
    constexpr float SCALE = ACfg<DQK>::SCALE;
    float pmax = p0[0]; for (int r = 1; r < 16; ++r) pmax = fmaxf(pmax, p0[r]); for (int r = 0; r < 16; ++r) pmax = fmaxf(pmax, p1[r]);
    { auto rr = __builtin_amdgcn_permlane32_swap(__float_as_uint(pmax), __float_as_uint(pmax), false, false);
      pmax = fmaxf(__uint_as_float(rr[0]), __uint_as_float(rr[1])); }
    constexpr float C2 = 1.4426950408889634f * SCALE;
    if (__builtin_expect(__all((pmax - m_reg) * SCALE <= THR), 1)) { mn = m_reg; alpha = 1.f; }
    else { mn = fmaxf(m_reg, pmax); alpha = __builtin_amdgcn_exp2f((m_reg - mn) * C2); m_reg = mn; }
    const float mnL = -mn * C2;
    for (int r = 0; r < 16; ++r) p0[r] = fmaf(p0[r], C2, mnL); for (int r = 0; r < 16; ++r) p1[r] = fmaf(p1[r], C2, mnL);
    for (int r = 0; r < 16; ++r) p0[r] = __builtin_amdgcn_exp2f(p0[r]);
}
template <int DQK, bool FOX>
__device__ __forceinline__ void qkt(f32x16& p0, f32x16& p1, const char* kl, const float* cb  , int r32, int hi, const bf16x8* qr) {
    if constexpr (FOX) {
#pragma unroll
        for (int i = 0; i < 4; ++i) { const f32x4 a = *(const f32x4*)(cb + 8 * i), b = *(const f32x4*)(cb + 32 + 8 * i);
            p0[4 * i] = a[0]; p0[4 * i + 1] = a[1]; p0[4 * i + 2] = a[2]; p0[4 * i + 3] = a[3];
            p1[4 * i] = b[0]; p1[4 * i + 1] = b[1]; p1[4 * i + 2] = b[2]; p1[4 * i + 3] = b[3]; }
    } else { p0 = f32x16{}; p1 = f32x16{}; }
    const char* krow = kl + r32 * 256; const int x16 = (r32 & 15) << 4;
#pragma unroll
    for (int d0 = 0; d0 < 8; ++d0) { const char* a = krow + (((d0 * 2 + hi) << 4) ^ x16);
        bf16x8 b0 = *reinterpret_cast<const bf16x8*>(a);
        bf16x8 b1 = *reinterpret_cast<const bf16x8*>(a + 32 * 256);
        p0 = __builtin_amdgcn_mfma_f32_32x32x16_bf16(b0, qr[d0], p0, 0, 0, 0);
        p1 = __builtin_amdgcn_mfma_f32_32x32x16_bf16(b1, qr[d0], p1, 0, 0, 0); }
    if constexpr (DQK == 192) {
        const char* rrow = kl + 16384 + r32 * 128; const int x8 = ((r32 >> 1) & 7) << 4;
#pragma unroll
        for (int d0 = 0; d0 < 4; ++d0) { const char* a = rrow + (((d0 * 2 + hi) << 4) ^ x8);
            bf16x8 b0 = *reinterpret_cast<const bf16x8*>(a);
            bf16x8 b1 = *reinterpret_cast<const bf16x8*>(a + 32 * 128);
            p0 = __builtin_amdgcn_mfma_f32_32x32x16_bf16(b0, qr[8 + d0], p0, 0, 0, 0);
            p1 = __builtin_amdgcn_mfma_f32_32x32x16_bf16(b1, qr[8 + d0], p1, 0, 0, 0); }
    }
}

__device__ __forceinline__ void pv_tile_d0(f32x16* o, int vb0, bf16x8 pa0, bf16x8 pa1, bf16x8 pa2, bf16x8 pa3) {
#define TRRD(dst, off) asm volatile("ds_read_b64_tr_b16 %0, %1 offset:%2" : "=&v"(dst) : "v"(vb0), "i"(off) : "memory")
#define PV_D0(d0) do { s16x4 l0, l1, l2, l3, h0, h1, h2, h3; constexpr int b_ = (d0) * 512;   \
        TRRD(l0, b_); TRRD(h0, b_ + 2048); TRRD(l1, b_ + 4096); TRRD(h1, b_ + 6144); TRRD(l2, b_ + 8192); TRRD(h2, b_ + 10240); TRRD(l3, b_ + 12288); TRRD(h3, b_ + 14336); \
        asm volatile("s_waitcnt lgkmcnt(0)" ::: "memory"); SBAR();   \
        o[d0] = __builtin_amdgcn_mfma_f32_32x32x16_bf16(pa0, (bf16x8){l0[0], l0[1], l0[2], l0[3], h0[0], h0[1], h0[2], h0[3]}, o[d0], 0, 0, 0);   \
        o[d0] = __builtin_amdgcn_mfma_f32_32x32x16_bf16(pa1, (bf16x8){l1[0], l1[1], l1[2], l1[3], h1[0], h1[1], h1[2], h1[3]}, o[d0], 0, 0, 0);   \
        o[d0] = __builtin_amdgcn_mfma_f32_32x32x16_bf16(pa2, (bf16x8){l2[0], l2[1], l2[2], l2[3], h2[0], h2[1], h2[2], h2[3]}, o[d0], 0, 0, 0);   \
        o[d0] = __builtin_amdgcn_mfma_f32_32x32x16_bf16(pa3, (bf16x8){l3[0], l3[1], l3[2], l3[3], h3[0], h3[1], h3[2], h3[3]}, o[d0], 0, 0, 0); } while (0)
    PV_D0(0); PV_D0(1); PV_D0(2); PV_D0(3);
#undef PV_D0
#undef TRRD
}
__device__ __forceinline__ void finishSM(f32x16& p0, f32x16& p1, float alpha, float& l_reg, bf16x8& pa0, bf16x8& pa1, bf16x8& pa2, bf16x8& pa3) {
    for (int r = 0; r < 16; ++r) p1[r] = __builtin_amdgcn_exp2f(p1[r]);
    float ps = 0; for (int r = 0; r < 16; ++r) ps += p0[r]; for (int r = 0; r < 16; ++r) ps += p1[r];
    { auto rr = __builtin_amdgcn_permlane32_swap(__float_as_uint(ps), __float_as_uint(ps), false, false);
      ps = __uint_as_float(rr[0]) + __uint_as_float(rr[1]); }
    l_reg = l_reg * alpha + ps;
#define PK4(P, B_, OUT) do { unsigned a0 = cvtpk(P[B_+0], P[B_+1]), a1 = cvtpk(P[B_+2], P[B_+3]);                          \
        unsigned b0 = cvtpk(P[B_+4], P[B_+5]), b1 = cvtpk(P[B_+6], P[B_+7]);                                             \
        auto r0 = __builtin_amdgcn_permlane32_swap(a0, b0, false, false); auto r1 = __builtin_amdgcn_permlane32_swap(a1, b1, false, false); \
        u32x4 w = {r0[0], r1[0], r0[1], r1[1]}; OUT = *reinterpret_cast<bf16x8*>(&w); } while (0)
    PK4(p0, 0, pa0); PK4(p0, 8, pa1); PK4(p1, 0, pa2); PK4(p1, 8, pa3);
#undef PK4
}
__device__ __forceinline__ void pv_tile(f32x16* o, int vb0  , bf16x8 pa0, bf16x8 pa1, bf16x8 pa2, bf16x8 pa3) {
#define TRRD(dst, off) asm volatile("ds_read_b64_tr_b16 %0, %1 offset:%2" : "=&v"(dst) : "v"(vb0), "i"(off) : "memory")
#define PV_RD(L, H, ks) do { constexpr int b_ = (ks) * 4096; TRRD(L[0], b_); TRRD(H[0], b_ + 2048); TRRD(L[1], b_ + 512); TRRD(H[1], b_ + 512 + 2048); \
        TRRD(L[2], b_ + 1024); TRRD(H[2], b_ + 1024 + 2048); TRRD(L[3], b_ + 1536); TRRD(H[3], b_ + 1536 + 2048); } while (0)
#define PV_MM(L, H, pa) do { _Pragma("unroll") for (int d0 = 0; d0 < 4; ++d0) \
        o[d0] = __builtin_amdgcn_mfma_f32_32x32x16_bf16(pa, (bf16x8){L[d0][0], L[d0][1], L[d0][2], L[d0][3], H[d0][0], H[d0][1], H[d0][2], H[d0][3]}, o[d0], 0, 0, 0); } while (0)
#define PV_WAIT(n) do { asm volatile("s_waitcnt lgkmcnt(" #n ")" ::: "memory"); SBAR(); } while (0)
    s16x4 la[4], ha[4], lb[4], hb[4];
    PV_RD(la, ha, 0); PV_RD(lb, hb, 1);
    PV_WAIT(8); PV_MM(la, ha, pa0); SBAR();
    PV_RD(la, ha, 2);
    PV_WAIT(8); PV_MM(lb, hb, pa1); SBAR();
    PV_RD(lb, hb, 3);
    PV_WAIT(8); PV_MM(la, ha, pa2); SBAR();
    PV_WAIT(0); PV_MM(lb, hb, pa3);
#undef PV_RD
#undef PV_MM
#undef PV_WAIT
#undef TRRD
}
constexpr int SEQ = 4096, NHEAD = 16, TOKP = 2048;
template <int DQK, bool FOX>
__device__ __forceinline__ void attn_phase(char* lds, LAS unsigned char* ldsl, const bf16* __restrict__ Q, const bf16* __restrict__ Kn, const bf16* __restrict__ Kr, const bf16* __restrict__ V,
                                           bf16* __restrict__ O, const float* __restrict__ logf, int G, int bid, const int wid) {
    constexpr int QP = NHEAD * DQK;
    constexpr int SLOT = DQK == 192 ? 40960 : 32768;
    constexpr int VOFF = DQK == 192 ? 24576 : 16384;
    constexpr bool PIPE = FOX;
    constexpr int KSZ = SLOT - 16384, VRING = 3 * KSZ;
    const int lane = lane_opaque(), tid = wid * 64 + lane, r32 = lane & 31, hi = lane >> 5;
    float* wsb = (float*)(lds + 3 * SLOT); float* ws = wsb + wid * 64; float* li_l = ws; float* al_l = ws + 32;
    float* Cb = wsb + 8 * 64;
    float* scn = Cb + 4096;
    unsigned koff0, koff1, voff0, voff1, roff;
    { const int q0 = wid * 128 + lane, q1 = q0 + 64;
      { const int row = q0 >> 4, src = (q0 & 15) ^ (row & 15); koff0 = (unsigned)(row * TOKP + src * 8) * 2u; }
      { const int row = q1 >> 4, src = (q1 & 15) ^ (row & 15); koff1 = (unsigned)(row * TOKP + src * 8) * 2u; }
      { const int s = q0 >> 5, w = q0 & 31, kk = (s >> 2) * 8 + (w >> 2), c = (s & 3) * 32 + (w & 3) * 8, k = (kk & ~0xC) | ((kk & 4) << 1) | ((kk & 8) >> 1); voff0 = (unsigned)(k * TOKP + c) * 2u; }
      { const int s = q1 >> 5, w = q1 & 31, kk = (s >> 2) * 8 + (w >> 2), c = (s & 3) * 32 + (w & 3) * 8, k = (kk & ~0xC) | ((kk & 4) << 1) | ((kk & 8) >> 1); voff1 = (unsigned)(k * TOKP + c) * 2u; }
      { const int q = wid * 64 + lane, row = q >> 3, src = (q & 7) ^ ((row >> 1) & 7); roff = (unsigned)(row * 64 + src * 8) * 2u; } }
    const int vrd = (int)(uintptr_t)lds + VOFF + v_rd_base(lane);
#define A_GLDS(gp_, lp_) __builtin_amdgcn_global_load_lds((const unsigned*)(gp_), (LAS unsigned*)(lp_), 16, 0, 0)
#define A_DMA(kb_, slot_) do { LAS unsigned char* d_ = ldsl + (slot_) * SLOT + wid * 2048; const char* kg_ = (const char*)(Kh + (size_t)(kb_) * TOKP); const char* vg_ = (const char*)(Vh + (size_t)(kb_) * TOKP); \
        A_GLDS(kg_ + koff0, d_); A_GLDS(kg_ + koff1, d_ + 1024);                                                        \
        if constexpr (DQK == 192) A_GLDS((const char*)(Krh + (size_t)(kb_) * 64) + roff, ldsl + (slot_) * SLOT + 16384 + wid * 1024); \
        A_GLDS(vg_ + voff0, d_ + VOFF); A_GLDS(vg_ + voff1, d_ + VOFF + 1024); } while (0)
#define A_DMAK(kb_, slot_) do { LAS unsigned char* d_ = ldsl + (slot_) * KSZ + wid * 2048; const char* kg_ = (const char*)(Kh + (size_t)(kb_) * TOKP);       \
        A_GLDS(kg_ + koff0, d_); A_GLDS(kg_ + koff1, d_ + 1024);                                                        \
        if constexpr (DQK == 192) A_GLDS((const char*)(Krh + (size_t)(kb_) * 64) + roff, ldsl + (slot_) * KSZ + 16384 + wid * 1024); } while (0)
#define A_DMAV(kb_, slot_) do { LAS unsigned char* d_ = ldsl + VRING + (slot_) * 16384 + wid * 2048; const char* vg_ = (const char*)(Vh + (size_t)(kb_) * TOKP); \
        A_GLDS(vg_ + voff0, d_); A_GLDS(vg_ + voff1, d_ + 1024); } while (0)
#define A_BAR() do { asm volatile("s_waitcnt lgkmcnt(0)" ::: "memory"); __builtin_amdgcn_s_barrier(); asm volatile("" ::: "memory"); } while (0)
#define A_VMW(n) do { if constexpr (DQK == 192) { if ((n) == 1) asm volatile("s_waitcnt vmcnt(5)" ::: "memory"); else asm volatile("s_waitcnt vmcnt(0)" ::: "memory"); } \
                      else { if ((n) == 1) asm volatile("s_waitcnt vmcnt(4)" ::: "memory"); else asm volatile("s_waitcnt vmcnt(0)" ::: "memory"); } } while (0)
    for (int L = bid; L < 512; L += G) {
        const int xcd = L & 7, idx = L >> 3, bh = xcd + 8 * (idx >> 3), x = idx & 7, b = bh >> 4, h = bh & 15;
        const size_t row0 = (size_t)b * SEQ;
        const bf16* Kh = Kn + row0 * TOKP + h * 128; const bf16* Vh = V + row0 * TOKP + h * 128; const bf16* Krh = Kr + row0 * 64;
        for (int pass = 0; pass < 2; ++pass) {
            const int qb = pass ? 15 - x : x, P0 = qb * 256, NT = P0 / 64 + 4;
            __syncthreads();
            if constexpr (PIPE) { A_DMAK(0, 0); A_DMAK(64, 1); A_DMAV(0, 0); A_DMAK(128, 2); A_DMAV(64, 1); }
            else { A_DMA(0, 0); A_DMA(64, 1); }
            if constexpr (FOX) {
                float v[8]; float s = 0.f; int k0 = tid * 8; asm volatile("" : "+v"(k0)); const bool on = k0 < P0 + 256;
#pragma unroll
                for (int j = 0; j < 8; ++j) { v[j] = on ? logf[(row0 + k0 + j) * 16 + h] : 0.f; }
#pragma unroll
                for (int j = 0; j < 8; ++j) { s += v[j]; v[j] = s; }
                float inc = s;
#pragma unroll
                for (int o_ = 1; o_ < 64; o_ <<= 1) { const float t_ = __shfl_up(inc, o_); if (lane >= o_) inc += t_; }
                if (lane == 63) scn[wid] = inc;
                __syncthreads();
                float base = inc - s;
                for (int w_ = 0; w_ < wid; ++w_) base += scn[w_];
                if (on) {
#pragma unroll
                    for (int j = 0; j < 8; ++j) Cb[k0 + j] = -(base + v[j]) * 11.313708498984761f;
                }
            }
            bf16x8 qr[DQK / 16];
            { int qoff = r32 * QP + hi * 8; asm volatile("" : "+v"(qoff));
              const bf16* qp = Q + (row0 + P0 + wid * 32) * QP + h * DQK + qoff;
#pragma unroll
              for (int d0 = 0; d0 < DQK / 16; ++d0) qr[d0] = *reinterpret_cast<const bf16x8*>(qp + d0 * 16); }
            asm volatile("s_waitcnt vmcnt(0)" ::: "memory");
#pragma unroll
            for (int d0 = 0; d0 < DQK / 16; ++d0) asm volatile("" : "+v"(qr[d0]));
            A_BAR();
            const int qlo = P0 + wid * 32, qloE = FOX ? qlo : (qlo | 63), qhiE = FOX ? qlo + 31 : (qlo | 63), qm = (FOX ? (qlo + r32) : ((qlo + r32) | 63)) - 4 * hi;
            float m_reg = -1e30f, l_reg = 0.f; f32x16 o[4] = {};
            f32x16 p0, p1; float mn, alpha; bf16x8 pa0, pa1, pa2, pa3;
#define A_RESC(a) do { if (__any((a) < 1.f)) { if (hi == 0) al_l[r32] = (a); asm volatile("s_waitcnt lgkmcnt(0)" ::: "memory");              \
                     for (int d_ = 0; d_ < 4; ++d_) for (int r = 0; r < 16; ++r) o[d_][r] *= al_l[crow(r, hi)]; } } while (0)
            if constexpr (PIPE) {
                const int vrp = (int)(uintptr_t)lds + VRING + v_rd_base(lane);
                f32x16 q0, q1; float alP, alQ;
                SBAR(); qkt<DQK, FOX>(p0, p1, lds, Cb + 4 * hi, r32, hi, qr); SBAR();
                if (63 > qloE) mask_tile(p0, p1, qm, 1u << 30);
                partialSM<DQK>(p0, p1, m_reg, mn, alP); SBAR();
                int s0 = 0, s1 = 1, s2 = 2;
#define A_PSTEP(t, LAST, PX0, PX1, alX, PY0, PY1, alY) do { const int kb_ = (t) * 64;                                      \
                    SBAR(); if (!(LAST)) qkt<DQK, FOX>(PY0, PY1, lds + s1 * KSZ, Cb + kb_ + 64 + 4 * hi, r32, hi, qr);     \
                    finishSM(PX0, PX1, alX, l_reg, pa0, pa1, pa2, pa3); SBAR();                                            \
                    { const int k3_ = ((t) + 3 < NT ? (t) + 3 : NT - 1) * 64, v2_ = ((t) + 2 < NT ? (t) + 2 : NT - 1) * 64; A_DMAK(k3_, s0); A_DMAV(v2_, s2); }   \
                    SBAR(); pv_tile_d0(o, vrp + s0 * 16384, pa0, pa1, pa2, pa3); SBAR();                                   \
                    if (!(LAST)) { if (kb_ + 127 > qloE) mask_tile(PY0, PY1, qm - kb_ - 64, 1u << 30);                     \
                        partialSM<DQK>(PY0, PY1, m_reg, mn, alY); A_RESC(alY); SBAR(); }                                   \
                    A_VMW(1); A_BAR();                                                                                     \
                    { const int t_ = s0; s0 = s1; s1 = s2; s2 = t_; } } while (0)
#pragma unroll 1
                for (int t = 0; t < NT - 2; t += 2) { A_PSTEP(t, false, p0, p1, alP, q0, q1, alQ); A_PSTEP(t + 1, false, q0, q1, alQ, p0, p1, alP); }
                A_PSTEP(NT - 2, false, p0, p1, alP, q0, q1, alQ); A_PSTEP(NT - 1, true, q0, q1, alQ, p0, p1, alP);
#undef A_PSTEP
            } else {
            int sc = 0, s2 = 2;
#pragma unroll 1
            for (int t = 0; t < NT; ++t) { const int kb_ = t * 64; const int kn_ = (t + 2 < NT ? t + 2 : NT - 1) * 64;
                const bool act_ = kb_ <= qhiE;
                if (act_) { SBAR(); qkt<DQK, FOX>(p0, p1, lds + sc * SLOT, Cb + kb_ + 4 * hi, r32, hi, qr); SBAR(); }
                A_DMA(kn_, s2);
                SBAR();
                if (act_) { if (kb_ + 63 > qloE) mask_tile(p0, p1, qm - kb_, 1u << 30);
                    partialSM<DQK>(p0, p1, m_reg, mn, alpha); finishSM(p0, p1, alpha, l_reg, pa0, pa1, pa2, pa3);
                    A_RESC(alpha); SBAR();
                    pv_tile(o, vrd + sc * SLOT, pa0, pa1, pa2, pa3); SBAR(); }
                A_VMW(1);
                A_BAR();
                sc = sc == 2 ? 0 : sc + 1; s2 = s2 == 2 ? 0 : s2 + 1; }
            }
            A_VMW(0);
            if (hi == 0) li_l[r32] = l_reg; asm volatile("s_waitcnt lgkmcnt(0)" ::: "memory");
            bf16* Ow = O + (row0 + P0 + wid * 32) * TOKP + h * 128;
            int obase = hi * 4 * TOKP + r32; asm volatile("" : "+v"(obase));
#pragma unroll
            for (int r = 0; r < 16; ++r) { const int orow = (r & 3) + 8 * (r >> 2); const float rl = __builtin_amdgcn_rcpf(li_l[orow + 4 * hi]);
#pragma unroll
                for (int d0 = 0; d0 < 4; ++d0) { const float v = o[d0][r] * rl; const float vn = __shfl_xor(v, 1);
                    if ((r32 & 1) == 0) *(unsigned*)(Ow + obase + orow * TOKP + d0 * 32) = cvtpk(v, vn); } }
#undef A_RESC
        }
    }
#undef A_GLDS
#undef A_DMA
#undef A_DMAK
#undef A_DMAV
#undef A_BAR
#undef A_VMW
}
#undef SBAR
}
typedef unsigned short bf16_t;
typedef float f32x4 __attribute__((ext_vector_type(4)));
typedef unsigned u32x4 __attribute__((ext_vector_type(4)));
typedef unsigned u32x2 __attribute__((ext_vector_type(2)));
constexpr int M = 16384, DM = 2048, FFH = 5632, NPH = 17;
constexpr float ALPHA = 1.4142135623730951f;
constexpr size_t MiB = 1u << 20;
constexpr size_t WS_WIN0 = 1 * MiB, WS_WQUP = 6 * MiB, WS_WKVUP = 9 * MiB, WS_WO0 = 13 * MiB, WS_WIN1 = 21 * MiB, WS_WO1 = 46 * MiB,
                 WS_WGU0 = 54 * MiB, WS_WGU1 = 98 * MiB, WS_WDN0 = 142 * MiB, WS_WDN1 = 164 * MiB, WS_TAB = 186 * MiB, WS_LOGF = 190 * MiB,
                 WS_PART = 191 * MiB, WS_XB = 192 * MiB, WS_R = 256 * MiB;
constexpr size_t WS_Q = WS_R, WS_H0 = WS_R, WS_K = WS_R + 96 * MiB, WS_V = WS_R + 160 * MiB, WS_O = WS_R + 224 * MiB, WS_CQN = WS_R + 288 * MiB, WS_CKVN = WS_R + 304 * MiB, WS_KROPE = WS_R + 320 * MiB;
constexpr size_t WS_FQ = WS_R, WS_FK = WS_R + 64 * MiB, WS_FV = WS_R + 128 * MiB, WS_HFF = WS_R;
constexpr int LDS_BYTES = 147456;
#ifndef GALIGN
#define GALIGN true
#endif
#ifndef GSP2
#define GSP2 true
#endif

__device__ __forceinline__ unsigned cvtpk2(float lo, float hi) { unsigned r; asm volatile("v_cvt_pk_bf16_f32 %0, %1, %2" : "=v"(r) : "v"(lo), "v"(hi)); return r; }
__device__ __forceinline__ float wave_sum(float v) {
#pragma unroll
    for (int o = 1; o < 64; o <<= 1) v += __shfl_xor(v, o);
    return v;
}
__device__ __forceinline__ void transpose_item(const float* __restrict__ W, int K, int nsrc, int ndst, bf16_t* __restrict__ WT, LAS unsigned char* scr, int item, int lane, int kind) {
    const int nblk = ndst / 64, kb = item / nblk, nb = item - kb * nblk, k0 = 128 * kb, n0 = 64 * nb;
    int src0 = n0; bool ropeblk = false;
    if (kind == 2) { const int t = n0 >> 8, bj = (n0 >> 7) & 1, j = n0 & 127; src0 = bj * FFH + t * 128 + j; }
    if (kind == 1) ropeblk = (n0 % 192) == 128;
    const int nn = (lane & 15) * 4, kp = lane >> 4; const bool valid = src0 + nn < nsrc;
    int pr[4];
#pragma unroll
    for (int e = 0; e < 4; ++e) { const int j = nn + e; pr[e] = (ropeblk ? (j < 32 ? 2 * j : 2 * (j - 32) + 1) : j) * 272 + kp * 4; }
    const float* wp = W + (size_t)(k0 + 2 * kp) * nsrc + src0 + nn;
#pragma unroll
    for (int h = 0; h < 2; ++h) { f32x4 va[8], vb[8];
#pragma unroll
        for (int i = 0; i < 8; ++i) { va[i] = (f32x4){0.f, 0.f, 0.f, 0.f}; vb[i] = va[i];
            if (valid) { const float* p = wp + (size_t)(8 * (8 * h + i)) * nsrc; va[i] = *(const f32x4*)p; vb[i] = *(const f32x4*)(p + nsrc); } }
#pragma unroll
        for (int i = 0; i < 8; ++i) { const int ko = (8 * h + i) * 16;
            *(LAS unsigned*)(scr + pr[0] + ko) = cvtpk2(va[i][0], vb[i][0]); *(LAS unsigned*)(scr + pr[1] + ko) = cvtpk2(va[i][1], vb[i][1]);
            *(LAS unsigned*)(scr + pr[2] + ko) = cvtpk2(va[i][2], vb[i][2]); *(LAS unsigned*)(scr + pr[3] + ko) = cvtpk2(va[i][3], vb[i][3]); } }
    asm volatile("s_waitcnt lgkmcnt(0)" ::: "memory");
#pragma unroll
    for (int j = 0; j < 16; ++j) { const int q = j * 64 + lane, row = q >> 4, c = q & 15;
        const u32x4 o = *(const LAS u32x4*)(scr + row * 272 + c * 16);
        *(u32x4*)(WT + (size_t)(n0 + row) * K + k0 + 8 * c) = o; }
    asm volatile("s_waitcnt lgkmcnt(0)" ::: "memory");
}
__device__ const float INV_FREQ[32] = {1.0f, 0.7498942017555237f, 0.5623413324356079f, 0.4216965138912201f, 0.3162277638912201f, 0.23713737726211548f, 0.17782793939113617f, 0.1333521455526352f, 0.10000000149011612f, 0.0749894231557846f, 0.05623413249850273f, 0.04216964915394783f, 0.03162277489900589f, 0.023713737726211548f, 0.017782794311642647f, 0.013335213996469975f, 0.009999999776482582f, 0.007498942315578461f, 0.005623413249850273f, 0.0042169648222625256f, 0.003162277629598975f, 0.0023713738191872835f, 0.0017782794311642647f, 0.0013335214462131262f, 0.0010000000474974513f, 0.0007498941849917173f, 0.000562341301701963f, 0.0004216965171508491f, 0.0003162277571391314f, 0.00023713737027719617f, 0.00017782794020604342f, 0.0001333521504420787f};

struct Args { const float* in[17]; const int* pos; float* out; unsigned char* ws; int ph_lo, ph_hi; };

__device__ __forceinline__ void phase_prep(const Args& a, unsigned char* ws, LAS unsigned char* ldsl, int bid, int G, int tid, int wid, int lane) {
    LAS unsigned char* scr = ldsl + wid * 17408;
    const int gw = bid * 8 + wid, NGW = G * 8;
    constexpr int I0 = 16 * 20, I1 = 4 * 48, I2 = 4 * 64, I3 = 16 * 32, I4 = 16 * 97, I5 = 16 * 32, I6 = 16 * 176, I8 = 44 * 32;
    constexpr int NIT = I0 + I1 + I2 + I3 + I4 + I5 + 2 * I6 + 2 * I8;
    for (int it = gw; it < NIT; it += NGW) {
        int r = it;
        if (r < I6) { transpose_item(a.in[11], 2048, 11264, 11264, (bf16_t*)(ws + WS_WGU0), scr, r, lane, 2); continue; } r -= I6;
        if (r < I6) { transpose_item(a.in[11] + (size_t)2048 * 11264, 2048, 11264, 11264, (bf16_t*)(ws + WS_WGU1), scr, r, lane, 2); continue; } r -= I6;
        if (r < I8) { transpose_item(a.in[12], 5632, 2048, 2048, (bf16_t*)(ws + WS_WDN0), scr, r, lane, 0); continue; } r -= I8;
        if (r < I8) { transpose_item(a.in[12] + (size_t)5632 * 2048, 5632, 2048, 2048, (bf16_t*)(ws + WS_WDN1), scr, r, lane, 0); continue; } r -= I8;
        if (r < I4) { transpose_item(a.in[8], 2048, 6160, 6208, (bf16_t*)(ws + WS_WIN1), scr, r, lane, 0); continue; } r -= I4;
        if (r < I0) { transpose_item(a.in[2], 2048, 1088, 1280, (bf16_t*)(ws + WS_WIN0), scr, r, lane, 0); continue; } r -= I0;
        if (r < I1) { transpose_item(a.in[4], 512, 3072, 3072, (bf16_t*)(ws + WS_WQUP), scr, r, lane, 1); continue; } r -= I1;
        if (r < I2) { transpose_item(a.in[6], 512, 4096, 4096, (bf16_t*)(ws + WS_WKVUP), scr, r, lane, 0); continue; } r -= I2;
        if (r < I3) { transpose_item(a.in[7], 2048, 2048, 2048, (bf16_t*)(ws + WS_WO0), scr, r, lane, 0); continue; } r -= I3;
        transpose_item(a.in[10], 2048, 2048, 2048, (bf16_t*)(ws + WS_WO1), scr, r, lane, 0);
    }
    { const f32x4* x4 = (const f32x4*)a.in[0]; u32x4* o = (u32x4*)(ws + WS_XB); const size_t n8 = (size_t)M * DM / 8;
      const size_t stride = (size_t)G * 512;
      for (size_t i = (size_t)bid * 512 + tid; i < n8; i += 4 * stride) { f32x4 v0[4], v1[4];
#pragma unroll
          for (int u = 0; u < 4; ++u) { const size_t j = i + u * stride; if (j < n8) { v0[u] = x4[2 * j]; v1[u] = x4[2 * j + 1]; } }
#pragma unroll
          for (int u = 0; u < 4; ++u) { const size_t j = i + u * stride; if (j < n8) { u32x4 w; w.x = cvtpk2(v0[u][0], v0[u][1]); w.y = cvtpk2(v0[u][2], v0[u][3]); w.z = cvtpk2(v1[u][0], v1[u][1]); w.w = cvtpk2(v1[u][2], v1[u][3]); o[j] = w; } } } }
    { float* tab = (float*)(ws + WS_TAB);
      for (int i = bid * 512 + tid; i < M * 32; i += G * 512) { const int row = i >> 5, j = i & 31;
          const float ang = (float)a.pos[row] * INV_FREQ[j]; const double ad = (double)ang;
          const double kq = __builtin_rint(ad * 0.15915494309189535); const float rf = (float)__builtin_fma(-kq, 6.283185307179586, ad);
          tab[2 * (size_t)i] = cosf(rf); tab[2 * (size_t)i + 1] = sinf(rf); } }
}
__device__ __forceinline__ void phase_ln(float* XR, bf16_t* xb, const float* __restrict__ g, const float* __restrict__ bta, int bid, int G, int wid, int lane) {
    const int gw = bid * 8 + wid, NGW = G * 8;
    for (int row = gw; row < M; row += NGW) {
        f32x4* xr = (f32x4*)(XR + (size_t)row * DM) + lane; f32x4 v[8]; float s = 0.f;
#pragma unroll
        for (int j = 0; j < 8; ++j) { v[j] = xr[64 * j]; s += (v[j][0] + v[j][1]) + (v[j][2] + v[j][3]); }
        const float mean = wave_sum(s) * (1.f / DM); float s2 = 0.f;
#pragma unroll
        for (int j = 0; j < 8; ++j) { v[j] = v[j] - mean; s2 += (v[j][0] * v[j][0] + v[j][1] * v[j][1]) + (v[j][2] * v[j][2] + v[j][3] * v[j][3]); }
        const float rstd = 1.0f / sqrtf(wave_sum(s2) * (1.f / DM) + 1e-5f);
        u32x2* ob = (u32x2*)(xb + (size_t)row * DM) + lane;
#pragma unroll
        for (int j = 0; j < 8; ++j) { const f32x4 gg = ((const f32x4*)g)[lane + 64 * j], bb = ((const f32x4*)bta)[lane + 64 * j]; const f32x4 y = v[j] * rstd * gg + bb;
            xr[64 * j] = y; u32x2 w; w.x = cvtpk2(y[0], y[1]); w.y = cvtpk2(y[2], y[3]); ob[64 * j] = w; }
    }
}
__device__ __forceinline__ void phase_mla_norm(const float* __restrict__ h0, bf16_t* cqn, bf16_t* ckvn, bf16_t* krope, const float* __restrict__ gq, const float* __restrict__ gkv, const float* __restrict__ tab,
                                               int bid, int G, int wid, int lane) {
    const int gw = bid * 8 + wid, NGW = G * 8;
    for (int row = gw; row < M; row += NGW) {
        const float* hr = h0 + (size_t)row * 1280;
#pragma unroll
        for (int part = 0; part < 2; ++part) {
            const f32x4 a0 = *(const f32x4*)(hr + part * 512 + lane * 8), a1 = *(const f32x4*)(hr + part * 512 + lane * 8 + 4);
            float ss = (a0[0] * a0[0] + a0[1] * a0[1]) + (a0[2] * a0[2] + a0[3] * a0[3]) + (a1[0] * a1[0] + a1[1] * a1[1]) + (a1[2] * a1[2] + a1[3] * a1[3]);
            const float rstd = 1.0f / sqrtf(wave_sum(ss) * (1.f / 512.f) + 1e-6f);
            const float* gp = (part ? gkv : gq) + lane * 8; const f32x4 g0 = *(const f32x4*)gp, g1 = *(const f32x4*)(gp + 4);
            const f32x4 y0 = a0 * rstd * g0, y1 = a1 * rstd * g1;
            u32x4 w; w.x = cvtpk2(y0[0], y0[1]); w.y = cvtpk2(y0[2], y0[3]); w.z = cvtpk2(y1[0], y1[1]); w.w = cvtpk2(y1[2], y1[3]);
            *(u32x4*)((part ? ckvn : cqn) + (size_t)row * 512 + lane * 8) = w;
        }
        if (lane < 32) { const float t1 = hr[1024 + lane], t2 = hr[1024 + 32 + lane]; const float c = tab[((size_t)row * 32 + lane) * 2], s = tab[((size_t)row * 32 + lane) * 2 + 1];
            *(unsigned*)(krope + (size_t)row * 64 + 2 * lane) = cvtpk2(t1 * c - t2 * s, t2 * c + t1 * s); }
    }
}

__global__ void __launch_bounds__(512) mega_fwd(Args a) {
    extern __shared__ __attribute__((aligned(16))) unsigned char lds[];
    cg::grid_group grid = cg::this_grid();
    const int wid = __builtin_amdgcn_readfirstlane(threadIdx.x >> 6), G = gridDim.x, bid = blockIdx.x;
#define LANE_TID const int lane = lane_opaque(), tid = wid * 64 + lane; (void)tid
    unsigned char* ws = a.ws; LAS unsigned char* ldsl = (LAS unsigned char*)lds;
    const int lo = a.ph_lo, hi = a.ph_hi;
    float* XR = a.out; bf16_t* xb = (bf16_t*)(ws + WS_XB);
#ifndef PHMASK
#define PHMASK 0x1ffff
#endif
#define IN(k) (((PHMASK >> (k)) & 1) && lo <= (k) && (k) < hi)
    volatile LAS unsigned* bst = (volatile LAS unsigned*)(ldsl + LDS_BYTES - 64);
    { LANE_TID; if (tid < 2) bst[tid] = 0u; }
    __syncthreads();
    XcdBarrier bar; bar.bar = (unsigned*)ws; bar.x = 0; bar.st = bst;
#define SEAM(k) do { if ((k) + 1 < hi) { const bool t0_ = (wid == 0) && (lane_opaque() == 0); if ((k) == 0) { grid.sync(); bar = xcd_barrier_post((unsigned*)ws, bst, t0_); } else xcd_barrier(bar, t0_); } } while (0)
#ifndef REP_PH
#define REP_PH -1
#define REP_N 0
#endif
#define REPS(k) for (int rep_ = 0; rep_ < ((k) == REP_PH ? 1 + REP_N : 1); ++rep_)
#define GEMM(EpiT, E, Ap, Bp, N_, K_) do { pg8::Gemm g_{(const bf16_t*)(Ap), (const bf16_t*)(Bp), M, (N_), (K_)}; pg8::StaticOrder S_; S_.init(M, (N_), G, bid); \
        pg8::gemm_phase<EpiT, pg8::StaticOrder, GALIGN, GSP2>(ldsl, g_, S_, E, wid); } while (0)
    const bool fusedLN = (G == 256) && lo == 0 && hi == NPH;
#ifndef XSKIP
#define XSKIP -1
#endif
#ifndef XSKIPV
#define XSKIPV 0.f
#endif
#define GEMM_LN(ph_, basep, Ap, Bp, K_, gp, bp) do { _Pragma("unroll 1") for (int r_ = 0; r_ < 2; ++r_) { pg8::Gemm g_{(const bf16_t*)(Ap), (const bf16_t*)(Bp), M, 2048, (K_)}; pg8::PanelRound S_{r_, bid}; \
        pg8::EpiResidLN E_{(basep), XR, (ph_) == 15 ? (bf16_t*)nullptr : xb, (gp), (bp), (float*)(ws + WS_PART), bar, ALPHA, (ph_) == XSKIP ? XSKIPV : 1.f}; pg8::gemm_phase<pg8::EpiResidLN, pg8::PanelRound, false, GSP2>(ldsl, g_, S_, E_, wid); __syncthreads(); } } while (0)
    if (IN(0)) { LANE_TID; if (bid == 0) { for (int i = tid; i < XCD_BAR_WORDS; i += 512) __hip_atomic_store((unsigned*)ws + i, 0u, __ATOMIC_RELAXED, __HIP_MEMORY_SCOPE_AGENT); }
#ifdef XPREP2
                 for (int q_ = 0; q_ < XPREP2; ++q_) { phase_prep(a, ws, ldsl, bid, G, tid, wid, lane); __syncthreads(); }
#endif
                 phase_prep(a, ws, ldsl, bid, G, tid, wid, lane); SEAM(0); }
    if (IN(1)) REPS(1) {
        if (fusedLN) {
            { const int lane = lane_opaque(), fr = lane & 15, fq = lane >> 4, hf = wid & 1; const float* tab = (const float*)(ws + WS_TAB); bf16_t* krope = (bf16_t*)(ws + WS_KROPE);
              for (int rg = bid * 4 + (wid >> 1); rg < M / 16; rg += G * 4) { f32x4 acc[2];
                  pg8::skinny_gemm<2>(xb, (const bf16_t*)(ws + WS_WIN0), 1024 + 16 * hf, 32, rg, lane, 0, 2048, acc);
                  const int row = rg * 16 + fr, j0 = 16 * hf + 4 * fq;
                  const f32x4 cs0 = *(const f32x4*)(tab + ((size_t)row * 32 + j0) * 2), cs1 = *(const f32x4*)(tab + ((size_t)row * 32 + j0 + 2) * 2);
                  const f32x4 t1 = acc[0], t2 = acc[1]; u32x4 w;
                  w.x = cvtpk2(t1[0] * cs0[0] - t2[0] * cs0[1], t2[0] * cs0[0] + t1[0] * cs0[1]); w.y = cvtpk2(t1[1] * cs0[2] - t2[1] * cs0[3], t2[1] * cs0[2] + t1[1] * cs0[3]);
                  w.z = cvtpk2(t1[2] * cs1[0] - t2[2] * cs1[1], t2[2] * cs1[0] + t1[2] * cs1[1]); w.w = cvtpk2(t1[3] * cs1[2] - t2[3] * cs1[3], t2[3] * cs1[2] + t1[3] * cs1[3]);
                  *(u32x4*)(krope + (size_t)row * 64 + 2 * j0) = w; } }
            pg8::Gemm g_{xb, (const bf16_t*)(ws + WS_WIN0), M, 1024, 2048}; pg8::QuadOrder S_{bid};
            pg8::EpiRms E_{(bf16_t*)(ws + WS_CQN), (bf16_t*)(ws + WS_CKVN), a.in[3], a.in[5], (float*)(ws + WS_PART), bar};
            pg8::gemm_phase<pg8::EpiRms, pg8::QuadOrder, false, GSP2>(ldsl, g_, S_, E_, wid);
        } else { pg8::EpiF32 E{(float*)(ws + WS_H0), 1280}; GEMM(pg8::EpiF32, E, xb, ws + WS_WIN0, 1280, 2048); }
        SEAM(1); }
    if (IN(2) && !fusedLN) REPS(2) { LANE_TID; phase_mla_norm((const float*)(ws + WS_H0), (bf16_t*)(ws + WS_CQN), (bf16_t*)(ws + WS_CKVN), (bf16_t*)(ws + WS_KROPE), a.in[3], a.in[5], (const float*)(ws + WS_TAB), bid, G, wid, lane); SEAM(2);
#ifdef XSYNC
        for (int q_ = 0; q_ < XSYNC; ++q_) xcd_barrier(bar, (wid == 0) && (lane_opaque() == 0));
#endif
    }
    if (IN(3)) REPS(3) { { pg8::EpiQrope E{(bf16_t*)(ws + WS_Q), (const float*)(ws + WS_TAB)}; GEMM(pg8::EpiQrope, E, ws + WS_CQN, ws + WS_WQUP, 3072, 512); }
                 __syncthreads();
                 { pg8::EpiKV E{(bf16_t*)(ws + WS_K), (bf16_t*)(ws + WS_V)}; GEMM(pg8::EpiKV, E, ws + WS_CKVN, ws + WS_WKVUP, 4096, 512); } SEAM(3); }
    if (IN(4)) REPS(4) { att::attn_phase<192, false>((char*)lds, ldsl, (const att::bf16*)(ws + WS_Q), (const att::bf16*)(ws + WS_K), (const att::bf16*)(ws + WS_KROPE), (const att::bf16*)(ws + WS_V), (att::bf16*)(ws + WS_O), nullptr, G, bid, wid); SEAM(4); }
    if (IN(5)) REPS(5) { if (fusedLN) GEMM_LN(5, a.in[0], ws + WS_O, ws + WS_WO0, 2048, a.in[13], a.in[14]); else { pg8::EpiResid E{a.in[0], XR, DM, ALPHA}; GEMM(pg8::EpiResid, E, ws + WS_O, ws + WS_WO0, 2048, 2048); } SEAM(5); }
    if (IN(6) && !fusedLN) REPS(6) { LANE_TID; phase_ln(XR, xb, a.in[13], a.in[14], bid, G, wid, lane); SEAM(6); }
    if (IN(7)) REPS(7) { pg8::EpiSwiglu E{(bf16_t*)(ws + WS_HFF), FFH}; GEMM(pg8::EpiSwiglu, E, xb, ws + WS_WGU0, 11264, 2048); SEAM(7); }
    if (IN(8)) REPS(8) { if (fusedLN) GEMM_LN(8, XR, ws + WS_HFF, ws + WS_WDN0, 5632, a.in[15], a.in[16]); else { pg8::EpiResid E{XR, XR, DM, ALPHA}; GEMM(pg8::EpiResid, E, ws + WS_HFF, ws + WS_WDN0, 2048, 5632); } SEAM(8); }
    if (IN(9) && !fusedLN) REPS(9) { LANE_TID; phase_ln(XR, xb, a.in[15], a.in[16], bid, G, wid, lane); SEAM(9); }
    if (IN(10)) REPS(10) { { pg8::EpiFoxIn E{(bf16_t*)(ws + WS_FQ), (size_t)(WS_FK - WS_FQ) / 2, (float*)(ws + WS_LOGF), a.in[9]}; GEMM(pg8::EpiFoxIn, E, xb, ws + WS_WIN1, 6144, 2048); }
        { const int lane = lane_opaque(), fr = lane & 15, fq = lane >> 4, hf = wid & 1; LAS f32x4* xch = (LAS f32x4*)ldsl; float* lf = (float*)(ws + WS_LOGF); const f32x4 bb = *(const f32x4*)(a.in[9] + 4 * fq);
          for (int rg = bid * 4 + (wid >> 1); rg < M / 16; rg += G * 4) { f32x4 acc[1];
              pg8::skinny_gemm<1>(xb, (const bf16_t*)(ws + WS_WIN1), 6144, 0, rg, lane, hf * 1024, hf * 1024 + 1024, acc);
              __syncthreads();
              if (hf) xch[(wid >> 1) * 64 + lane] = acc[0];
              __syncthreads();
              if (!hf) { const f32x4 x = acc[0] + xch[(wid >> 1) * 64 + lane] + bb; f32x4 o; o[0] = pg8::lsig(x[0]); o[1] = pg8::lsig(x[1]); o[2] = pg8::lsig(x[2]); o[3] = pg8::lsig(x[3]);
                  *(f32x4*)(lf + (size_t)(rg * 16 + fr) * 16 + 4 * fq) = o; } } }
        SEAM(10); }
    if (IN(11)) REPS(11) { att::attn_phase<128, true>((char*)lds, ldsl, (const att::bf16*)(ws + WS_FQ), (const att::bf16*)(ws + WS_FK), nullptr, (const att::bf16*)(ws + WS_FV), (att::bf16*)(ws + WS_O), (const float*)(ws + WS_LOGF), G, bid, wid); SEAM(11); }
    if (IN(12)) REPS(12) { if (fusedLN) GEMM_LN(12, XR, ws + WS_O, ws + WS_WO1, 2048, a.in[13] + DM, a.in[14] + DM); else { pg8::EpiResid E{XR, XR, DM, ALPHA}; GEMM(pg8::EpiResid, E, ws + WS_O, ws + WS_WO1, 2048, 2048); } SEAM(12); }
    if (IN(13) && !fusedLN) REPS(13) { LANE_TID; phase_ln(XR, xb, a.in[13] + DM, a.in[14] + DM, bid, G, wid, lane); SEAM(13); }
    if (IN(14)) REPS(14) { pg8::EpiSwiglu E{(bf16_t*)(ws + WS_HFF), FFH}; GEMM(pg8::EpiSwiglu, E, xb, ws + WS_WGU1, 11264, 2048); SEAM(14); }
    if (IN(15)) REPS(15) { if (fusedLN) GEMM_LN(15, XR, ws + WS_HFF, ws + WS_WDN1, 5632, a.in[15] + DM, a.in[16] + DM); else { pg8::EpiResid E{XR, XR, DM, ALPHA}; GEMM(pg8::EpiResid, E, ws + WS_HFF, ws + WS_WDN1, 2048, 5632); SEAM(15); } }
    if (IN(16) && !fusedLN) REPS(16) { LANE_TID; phase_ln(XR, xb, a.in[15] + DM, a.in[16] + DM, bid, G, wid, lane); }
#undef IN
#undef SEAM
#undef GEMM
#undef GEMM_LN
}

extern "C" void kernel_launch(void* const* d_in, const int* in_sizes, int n_in, void* d_out, int out_size, void* d_ws, size_t ws_size, hipStream_t stream) {
    static int grid = 0;
    if (grid == 0) {
        int dev = 0, cus = 0, per_cu = 0;
        (void)hipGetDevice(&dev); (void)hipDeviceGetAttribute(&cus, hipDeviceAttributeMultiprocessorCount, dev);
        if (hipFuncSetAttribute((const void*)mega_fwd, hipFuncAttributeMaxDynamicSharedMemorySize, LDS_BYTES) != hipSuccess) fprintf(stderr, "kernel_launch: hipFuncSetAttribute failed\n");
        if (hipOccupancyMaxActiveBlocksPerMultiprocessor(&per_cu, (const void*)mega_fwd, 512, LDS_BYTES) != hipSuccess || per_cu < 1) { fprintf(stderr, "kernel_launch: occupancy query says %d\n", per_cu); per_cu = 1; }
        (void)hipGetLastError();
        if (cus <= 0) cus = 256;
        grid = cus * per_cu;
        if (n_in != 17 || ws_size < 600 * MiB) fprintf(stderr, "kernel_launch: unexpected n_in %d / ws %zu\n", n_in, ws_size);
    }
    Args a{};
    for (int i = 0; i < 17; ++i) a.in[i] = (const float*)d_in[i];
    a.pos = (const int*)d_in[1]; a.out = (float*)d_out; a.ws = (unsigned char*)d_ws;
#if ONE_LAUNCH
    a.ph_lo = 0; a.ph_hi = NPH; { void* args[] = {&a}; hipError_t e = hipLaunchCooperativeKernel((const void*)mega_fwd, dim3(grid), dim3(512), args, LDS_BYTES, stream);
      if (e != hipSuccess) fprintf(stderr, "cooperative launch failed: %s (grid %d)\n", hipGetErrorString(e), grid); }
#else
    for (int k = 0; k < NPH; ++k) { a.ph_lo = k; a.ph_hi = k + 1; void* args[] = {&a}; hipError_t e = hipLaunchCooperativeKernel((const void*)mega_fwd, dim3(grid), dim3(512), args, LDS_BYTES, stream);
      if (e != hipSuccess) { fprintf(stderr, "cooperative launch %d failed: %s (grid %d)\n", k, hipGetErrorString(e), grid); break; } }
#endif
}
```

```cpp
#include <hip/hip_runtime.h>
#include <hip/hip_cooperative_groups.h>
#include <hip/hip_bf16.h>
#include <cstdio>
#include <cstdint>
namespace cg = cooperative_groups;
#ifndef ONE_LAUNCH
#define ONE_LAUNCH 1
#endif
__device__ __forceinline__ int lane_opaque() { int l; asm volatile("v_mbcnt_lo_u32_b32 %0, -1, 0\n\tv_mbcnt_hi_u32_b32 %0, -1, %0" : "=v"(l)); return l; }
#define LAS __attribute__((address_space(3)))
#define XB_TMO      128
#define XB_XCNT(j)  (256  + 64 * (j))
#define XB_XSUB(j)  (1280 + 64 * (j))
#define XB_XGEN(j)  (2304 + 64 * (j))
#define XB_TOP      3328
#define XB_TOPGEN   3392
#define XCD_BAR_WORDS 3456
#define XB_SPIN_CAP (1u << 18)

__device__ __forceinline__ unsigned xb_ld(unsigned* p)              { return __hip_atomic_load(p, __ATOMIC_RELAXED, __HIP_MEMORY_SCOPE_AGENT); }
__device__ __forceinline__ unsigned xb_add(unsigned* p, unsigned v) { return __hip_atomic_fetch_add(p, v, __ATOMIC_RELAXED, __HIP_MEMORY_SCOPE_AGENT); }
__device__ __forceinline__ unsigned xb_xcc_id() { return (unsigned)__builtin_amdgcn_s_getreg((3 << 11) | 20) & 0xFu; }
#define XB_SPIN(cond, bar) do { unsigned _sp = 0; while (cond) { __builtin_amdgcn_s_sleep(1); \
    if ((++_sp & 255u) == 0u) { if (xb_ld(&(bar)[XB_TMO])) break; if (_sp > XB_SPIN_CAP) { atomicAdd(&(bar)[XB_TMO], 1u); break; } } } } while (0)

struct XcdBarrier {
    unsigned* bar; unsigned x;
    volatile LAS unsigned* st;
};

__device__ __forceinline__ XcdBarrier xcd_barrier_post(unsigned* bar, volatile LAS unsigned* st, const bool t0) {
    XcdBarrier b; b.bar = bar; b.x = xb_xcc_id(); b.st = st;
    if (t0) (void)xb_add(&bar[XB_XCNT(b.x)], 1u);
    return b;
}
__device__ __forceinline__ void xcd_barrier_complete(unsigned* bar, unsigned x, unsigned& nloc, unsigned& nx) {
    const unsigned G = gridDim.x * gridDim.y * gridDim.z;
    unsigned sum, cnt, mine, sp = 0u;
    for (;;) {
        sum = 0u; cnt = 0u; mine = 0u;
#pragma unroll
        for (unsigned j = 0; j < 16; ++j) { const unsigned c = xb_ld(&bar[XB_XCNT(j)]); sum += c; cnt += (c > 0u) ? 1u : 0u; mine = (j == x) ? c : mine; }
        if (sum == G) break;
        __builtin_amdgcn_s_sleep(1);
        if ((++sp & 255u) == 0u) { if (xb_ld(&bar[XB_TMO])) break; if (sp > XB_SPIN_CAP) { atomicAdd(&bar[XB_TMO], 1u); break; } }
    }
    nloc = mine > 0u ? mine : 1u; nx = cnt > 0u ? cnt : 1u;
}

__device__ __forceinline__ void xcd_barrier(const XcdBarrier& b, const bool t0) {
    asm volatile("s_waitcnt vmcnt(0)" ::: "memory");
    __syncthreads();
    if (t0) {
        unsigned* bar = b.bar;
        __builtin_amdgcn_s_waitcnt(0);
        unsigned nloc = b.st[0], nx = b.st[1];
        if (nloc == 0u) { xcd_barrier_complete(bar, b.x, nloc, nx); b.st[0] = nloc; b.st[1] = nx; }
        const unsigned old = xb_add(&bar[XB_XSUB(b.x)], 1u);
        const unsigned gen = old / nloc;
        if (old + 1u == (gen + 1u) * nloc) {
            __builtin_amdgcn_fence(__ATOMIC_RELEASE, "agent");
            asm volatile("s_waitcnt vmcnt(0)" ::: "memory");
            const unsigned og = xb_add(&bar[XB_TOP], 1u);
            const unsigned tg = og / nx;
            if (og + 1u == (tg + 1u) * nx) xb_add(&bar[XB_TOPGEN], 1u);
            else XB_SPIN(xb_ld(&bar[XB_TOPGEN]) == tg, bar);
            __builtin_amdgcn_fence(__ATOMIC_ACQUIRE, "agent");
            xb_add(&bar[XB_XGEN(b.x)], 1u);
            asm volatile("s_waitcnt vmcnt(0)" ::: "memory");
        } else {
            XB_SPIN(xb_ld(&bar[XB_XGEN(b.x)]) == gen, bar);
            __builtin_amdgcn_fence(__ATOMIC_ACQUIRE, "agent");
            asm volatile("s_waitcnt vmcnt(0)" ::: "memory");
        }
    }
    __syncthreads();
}
namespace pg8 {
#define PG8_LAS __attribute__((address_space(3)))
typedef unsigned short bf16_t;
typedef short bf16x8 __attribute__((ext_vector_type(8)));
typedef float f32x4 __attribute__((ext_vector_type(4)));
typedef unsigned u32x4 __attribute__((ext_vector_type(4)));
constexpr int BM = 256, BK = 64, HALF = 128, HTB = HALF * BK * 2  , STAGE_BYTES = 8 * HTB, NXCD = 8, WGM = 8;

__host__ __device__ __forceinline__ int lds_byte(int r, int c) { const int st = (r >> 4) * 2 + (c >> 5), rr = r & 15, cc = c & 31, ob = rr * 64 + cc * 2; return st * 1024 + (ob ^ (((ob >> 9) & 1) << 5)); }
__host__ __device__ __forceinline__ void stage_rc(int b, int& R, int& C) { const int st = b / 1024, sb = b % 1024, swz = sb ^ (((sb >> 9) & 1) << 5); R = (st >> 1) * 16 + swz / 64; C = (st & 1) * 32 + (swz % 64) / 2; }
__host__ __device__ __forceinline__ int perm32(int rho) { const int n = rho >> 4, i = rho & 15; return 8 * (i >> 2) + 4 * n + (i & 3); }

struct Unit { int pm, pn; };
struct Gemm { const bf16_t* A; const bf16_t* Bt; int M, N, K; };

struct StaticOrder {
    int nM, nN, nwg, G, c;
    __host__ __device__ void init(int M, int N, int G_, int c_) { nM = M / BM; nN = N / BM; nwg = nM * nN; G = G_; c = c_; }
    __host__ __device__ bool next(int i, Unit& u) const {
        const long L = (long)i * G + c; if (L >= nwg) return false;
        int wgid = (int)L; { const int q = nwg / NXCD, r = nwg % NXCD, xcd = wgid % NXCD, off = wgid / NXCD; wgid = (xcd < r ? xcd * (q + 1) : r * (q + 1) + (xcd - r) * q) + off; }
        const int nig = WGM * nN, gid = wgid / nig, fm = gid * WGM, gsz = (nM - fm) < WGM ? (nM - fm) : WGM;
        u.pm = fm + ((wgid % nig) % gsz); u.pn = (wgid % nig) / gsz; return true;
    }
    __device__ __forceinline__ void a_ready(const Unit&) const {}
    __device__ __forceinline__ void done(const Unit&) const {}
};

__device__ __forceinline__ unsigned cvt_pk_bf16(float lo, float hi) { unsigned r; asm volatile("v_cvt_pk_bf16_f32 %0, %1, %2" : "=v"(r) : "v"(lo), "v"(hi)); return r; }
typedef float f32x2 __attribute__((ext_vector_type(2)));
typedef unsigned u32x2 __attribute__((ext_vector_type(2)));
struct EpiF32 {
    static constexpr bool PERM = false, AFTER_DRAIN = false;
    float* O; int ldc;
    __device__ __forceinline__ void operator()(const f32x4 (&acc)[2][2][4][2], const Unit& u, int wr, int wc, int fr, int fq) const {
        const int row0 = u.pm * BM + wr * 64 + fr, col0 = u.pn * BM + wc * 32 + 4 * fq;
#pragma unroll
        for (int ai = 0; ai < 2; ++ai)
#pragma unroll
            for (int m = 0; m < 4; ++m) { float* rowp = O + (size_t)(row0 + ai * HALF + m * 16) * ldc + col0;
#pragma unroll
                for (int bj = 0; bj < 2; ++bj)
#pragma unroll
                    for (int n = 0; n < 2; ++n) *(f32x4*)(rowp + bj * HALF + n * 16) = acc[ai][bj][m][n]; }
    }
};
struct EpiResid {
    static constexpr bool PERM = false, AFTER_DRAIN = false;
    const float* base; float* out; int ldc; float alpha;
    __device__ __forceinline__ void operator()(const f32x4 (&acc)[2][2][4][2], const Unit& u, int wr, int wc, int fr, int fq) const {
        const int row0 = u.pm * BM + wr * 64 + fr, col0 = u.pn * BM + wc * 32 + 4 * fq;
#pragma unroll
        for (int ai = 0; ai < 2; ++ai)
#pragma unroll
            for (int m = 0; m < 4; ++m) { const size_t off = (size_t)(row0 + ai * HALF + m * 16) * ldc + col0;
                f32x4 b[2][2];
#pragma unroll
                for (int bj = 0; bj < 2; ++bj)
#pragma unroll
                    for (int n = 0; n < 2; ++n) b[bj][n] = *(const f32x4*)(base + off + bj * HALF + n * 16);
#pragma unroll
                for (int bj = 0; bj < 2; ++bj)
#pragma unroll
                    for (int n = 0; n < 2; ++n) *(f32x4*)(out + off + bj * HALF + n * 16) = b[bj][n] * alpha + acc[ai][bj][m][n]; }
    }
};
__device__ __forceinline__ float silu_mul(float g, float u) { return g * __builtin_amdgcn_rcpf(1.0f + __builtin_amdgcn_exp2f(-1.4426950408889634f * g)) * u; }
struct EpiSwiglu {
    static constexpr bool PERM = true, AFTER_DRAIN = false;
    bf16_t* O; int ldc;
    __device__ __forceinline__ void operator()(const f32x4 (&acc)[2][2][4][2], const Unit& u, int wr, int wc, int fr, int fq) const {
        const int row0 = u.pm * BM + wr * 64 + fr, col0 = u.pn * HALF + wc * 32 + 8 * fq;
#pragma unroll
        for (int ai = 0; ai < 2; ++ai)
#pragma unroll
            for (int m = 0; m < 4; ++m) { bf16_t* rowp = O + (size_t)(row0 + ai * HALF + m * 16) * ldc + col0;
                const f32x4 g0 = acc[ai][0][m][0], g1 = acc[ai][0][m][1], u0 = acc[ai][1][m][0], u1 = acc[ai][1][m][1];
                u32x4 w; w.x = cvt_pk_bf16(silu_mul(g0[0], u0[0]), silu_mul(g0[1], u0[1])); w.y = cvt_pk_bf16(silu_mul(g0[2], u0[2]), silu_mul(g0[3], u0[3]));
                w.z = cvt_pk_bf16(silu_mul(g1[0], u1[0]), silu_mul(g1[1], u1[1])); w.w = cvt_pk_bf16(silu_mul(g1[2], u1[2]), silu_mul(g1[3], u1[3]));
#ifdef XNT
                __builtin_nontemporal_store(w, (u32x4*)rowp); }
#else
                *(u32x4*)rowp = w; }
#endif
    }
};
__device__ __forceinline__ u32x4 pack8bf(const f32x4 v0, const f32x4 v1) { u32x4 w; w.x = cvt_pk_bf16(v0[0], v0[1]); w.y = cvt_pk_bf16(v0[2], v0[3]); w.z = cvt_pk_bf16(v1[0], v1[1]); w.w = cvt_pk_bf16(v1[2], v1[3]); return w; }
struct EpiKV {
    static constexpr bool PERM = true, AFTER_DRAIN = false;
    bf16_t* Kb; bf16_t* Vb;
    __device__ __forceinline__ void operator()(const f32x4 (&acc)[2][2][4][2], const Unit& u, int wr, int wc, int fr, int fq) const {
        const int row0 = u.pm * BM + wr * 64 + fr, col0 = u.pn * HALF + wc * 32 + 8 * fq;
#pragma unroll
        for (int ai = 0; ai < 2; ++ai)
#pragma unroll
            for (int m = 0; m < 4; ++m) { const size_t off = (size_t)(row0 + ai * HALF + m * 16) * 2048 + col0;
                *(u32x4*)(Kb + off) = pack8bf(acc[ai][0][m][0], acc[ai][0][m][1]);
                *(u32x4*)(Vb + off) = pack8bf(acc[ai][1][m][0], acc[ai][1][m][1]); }
    }
};
struct EpiQrope {
    static constexpr bool PERM = true, AFTER_DRAIN = false;
    bf16_t* O; const float* tab;
    __device__ __forceinline__ void operator()(const f32x4 (&acc)[2][2][4][2], const Unit& u, int wr, int wc, int fr, int fq) const {
        const int row0 = u.pm * BM + wr * 64 + fr;
#pragma unroll
        for (int bj = 0; bj < 2; ++bj) {
            const int col0 = u.pn * BM + bj * HALF + wc * 32 + 8 * fq; const int w = col0 % 192; const bool rope = w >= 128; const int j0 = (w - 128) >> 1;
#pragma unroll
            for (int ai = 0; ai < 2; ++ai)
#pragma unroll
                for (int m = 0; m < 4; ++m) { const int row = row0 + ai * HALF + m * 16;
                    f32x4 v0 = acc[ai][bj][m][0], v1 = acc[ai][bj][m][1];
                    if (rope) { const f32x4 cs0 = *(const f32x4*)(tab + ((size_t)row * 32 + j0) * 2), cs1 = *(const f32x4*)(tab + ((size_t)row * 32 + j0 + 2) * 2);
                        f32x4 r0, r1;
                        r0[0] = v0[0] * cs0[0] - v0[1] * cs0[1]; r0[1] = v0[1] * cs0[0] + v0[0] * cs0[1];
                        r0[2] = v0[2] * cs0[2] - v0[3] * cs0[3]; r0[3] = v0[3] * cs0[2] + v0[2] * cs0[3];
                        r1[0] = v1[0] * cs1[0] - v1[1] * cs1[1]; r1[1] = v1[1] * cs1[0] + v1[0] * cs1[1];
                        r1[2] = v1[2] * cs1[2] - v1[3] * cs1[3]; r1[3] = v1[3] * cs1[2] + v1[2] * cs1[3];
                        v0 = r0; v1 = r1; }
                    *(u32x4*)(O + (size_t)row * 3072 + col0) = pack8bf(v0, v1); }
        }
    }
};
__device__ __forceinline__ float lsig(float x) { return fminf(x, 0.f) - 0.6931471805599453f * __builtin_amdgcn_logf(1.0f + __builtin_amdgcn_exp2f(-1.4426950408889634f * fabsf(x))); }
struct EpiFoxIn {
    static constexpr bool PERM = true, AFTER_DRAIN = false;
    bf16_t* QKV; size_t stride; float* logf; const float* bf;
    __device__ __forceinline__ void operator()(const f32x4 (&acc)[2][2][4][2], const Unit& u, int wr, int wc, int fr, int fq) const {
        const int row0 = u.pm * BM + wr * 64 + fr;
        if (u.pn < 24) {
            bf16_t* base = QKV + (size_t)(u.pn >> 3) * stride; const int colt = (u.pn & 7) * BM + wc * 32 + 8 * fq;
#pragma unroll
            for (int ai = 0; ai < 2; ++ai)
#pragma unroll
                for (int m = 0; m < 4; ++m) { bf16_t* rowp = base + (size_t)(row0 + ai * HALF + m * 16) * 2048 + colt;
#pragma unroll
                    for (int bj = 0; bj < 2; ++bj) *(u32x4*)(rowp + bj * HALF) = pack8bf(acc[ai][bj][m][0], acc[ai][bj][m][1]); }
        } else if (wc == 0 && fq < 2) {
#pragma unroll
            for (int ai = 0; ai < 2; ++ai)
#pragma unroll
                for (int m = 0; m < 4; ++m) { const int row = row0 + ai * HALF + m * 16;
#pragma unroll
                    for (int n = 0; n < 2; ++n) { const int c = 8 * fq + 4 * n; const f32x4 bb = *(const f32x4*)(bf + c); const f32x4 x = acc[ai][0][m][n] + bb; f32x4 o;
                        o[0] = lsig(x[0]); o[1] = lsig(x[1]); o[2] = lsig(x[2]); o[3] = lsig(x[3]);
                        *(f32x4*)(logf + (size_t)row * 16 + c) = o; } }
        }
    }
};

struct EpiResidLN {
    static constexpr bool PERM = false, AFTER_DRAIN = true;
    const float* base; float* out; bf16_t* xb; const float* g; const float* bt; float* part  ; XcdBarrier bar; float alpha; float accs;
    __device__ __forceinline__ void fused(f32x4 (&acc)[2][2][4][2], const Unit& u, int wr, int wc, int fr, int fq, PG8_LAS unsigned char* lds, int wid, int lane) const {
        PG8_LAS f32x2* P = (PG8_LAS f32x2*)lds;
        PG8_LAS f32x2* S = (PG8_LAS f32x2*)(lds + 8192);
        const int col0 = u.pn * BM + wc * 32 + 4 * fq;
#pragma unroll
        for (int ai = 0; ai < 2; ++ai)
#pragma unroll
            for (int m = 0; m < 4; ++m) { const size_t off = (size_t)(u.pm * BM + ai * HALF + wr * 64 + m * 16 + fr) * 2048 + col0;
                float s = 0.f, q = 0.f;
#pragma unroll
                for (int bj = 0; bj < 2; ++bj)
#pragma unroll
                    for (int n = 0; n < 2; ++n) { const f32x4 b = *(const f32x4*)(base + off + bj * HALF + n * 16); const f32x4 v = b * alpha + acc[ai][bj][m][n] * accs; acc[ai][bj][m][n] = v;
                        s += (v[0] + v[1]) + (v[2] + v[3]); q += (v[0] * v[0] + v[1] * v[1]) + (v[2] * v[2] + v[3] * v[3]); }
                s += __shfl_xor(s, 16); s += __shfl_xor(s, 32); q += __shfl_xor(q, 16); q += __shfl_xor(q, 32);
                if (fq == 0) P[(ai * HALF + wr * 64 + m * 16 + fr) * 4 + wc] = (f32x2){s, q};
                if (m & 1) asm volatile("" ::: "memory"); }
        asm volatile("s_waitcnt lgkmcnt(0)" ::: "memory"); __builtin_amdgcn_s_barrier(); asm volatile("" ::: "memory");
        const int tid = wid * 64 + lane;
        if (tid < 256) { const f32x2 a = P[tid * 4 + 0], b = P[tid * 4 + 1], c = P[tid * 4 + 2], d = P[tid * 4 + 3];
            const float s = (a.x + b.x) + (c.x + d.x), q = (a.y + b.y) + (c.y + d.y);
            unsigned long long* slot = (unsigned long long*)part + ((size_t)(u.pm * BM + tid) * 8 + u.pn);
            __hip_atomic_store(slot, ((unsigned long long)__float_as_uint(q) << 32) | __float_as_uint(s), __ATOMIC_RELAXED, __HIP_MEMORY_SCOPE_AGENT); }
        xcd_barrier(bar, tid == 0);
        if (tid < 256) { const unsigned long long* slot = (const unsigned long long*)part + (size_t)(u.pm * BM + tid) * 8; float s = 0.f, q = 0.f;
#pragma unroll
            for (int t = 0; t < 8; ++t) { const unsigned long long w = __hip_atomic_load(slot + t, __ATOMIC_RELAXED, __HIP_MEMORY_SCOPE_AGENT); s += __uint_as_float((unsigned)w); q += __uint_as_float((unsigned)(w >> 32)); }
            const float mean = s * (1.f / 2048.f), var = fmaxf(q * (1.f / 2048.f) - mean * mean, 0.f);
            S[tid] = (f32x2){mean, 1.0f / sqrtf(var + 1e-5f)}; }
        asm volatile("s_waitcnt lgkmcnt(0)" ::: "memory"); __builtin_amdgcn_s_barrier(); asm volatile("" ::: "memory");
        f32x4 gg[2][2], bb[2][2];
#pragma unroll
        for (int bj = 0; bj < 2; ++bj)
#pragma unroll
            for (int n = 0; n < 2; ++n) { gg[bj][n] = *(const f32x4*)(g + col0 + bj * HALF + n * 16); bb[bj][n] = *(const f32x4*)(bt + col0 + bj * HALF + n * 16); }
#pragma unroll
        for (int ai = 0; ai < 2; ++ai)
#pragma unroll
            for (int m = 0; m < 4; ++m) { const int r = ai * HALF + wr * 64 + m * 16 + fr; const f32x2 sr = S[r]; const size_t off = (size_t)(u.pm * BM + r) * 2048 + col0;
#pragma unroll
                for (int bj = 0; bj < 2; ++bj)
#pragma unroll
                    for (int n = 0; n < 2; ++n) { const f32x4 o = (acc[ai][bj][m][n] - sr.x) * sr.y * gg[bj][n] + bb[bj][n];
                        *(f32x4*)(out + off + bj * HALF + n * 16) = o; if (xb) { u32x2 w; w.x = cvt_pk_bf16(o[0], o[1]); w.y = cvt_pk_bf16(o[2], o[3]); *(u32x2*)(xb + off + bj * HALF + n * 16) = w; } } }
    }
};
struct PanelRound {
    int r, c;
    __device__ bool next(int i, Unit& u) const { if (i != 0) return false; const int x = c & 7, j = c >> 3; u.pm = r * 32 + x * 4 + (j & 3); u.pn = j >> 2; return true; }
    __device__ __forceinline__ void a_ready(const Unit&) const {}
    __device__ __forceinline__ void done(const Unit&) const {}
};

struct EpiRms {
    static constexpr bool PERM = true, AFTER_DRAIN = true;
    bf16_t* cqn; bf16_t* ckvn; const float* gq; const float* gkv; float* part  ; XcdBarrier bar;
    __device__ __forceinline__ void fused(f32x4 (&acc)[2][2][4][2], const Unit& u, int wr, int wc, int fr, int fq, PG8_LAS unsigned char* lds, int wid, int lane) const {
        PG8_LAS float* P = (PG8_LAS float*)lds;
        PG8_LAS float* S = (PG8_LAS float*)(lds + 4096);
#pragma unroll
        for (int ai = 0; ai < 2; ++ai)
#pragma unroll
            for (int m = 0; m < 4; ++m) { float q = 0.f;
#pragma unroll
                for (int bj = 0; bj < 2; ++bj)
#pragma unroll
                    for (int n = 0; n < 2; ++n) { const f32x4 v = acc[ai][bj][m][n]; q += (v[0] * v[0] + v[1] * v[1]) + (v[2] * v[2] + v[3] * v[3]); }
                q += __shfl_xor(q, 16); q += __shfl_xor(q, 32);
                if (fq == 0) P[(ai * HALF + wr * 64 + m * 16 + fr) * 4 + wc] = q; }
        asm volatile("s_waitcnt lgkmcnt(0)" ::: "memory"); __builtin_amdgcn_s_barrier(); asm volatile("" ::: "memory");
        const int tid = wid * 64 + lane;
        if (tid < 256) { const float q = (P[tid * 4 + 0] + P[tid * 4 + 1]) + (P[tid * 4 + 2] + P[tid * 4 + 3]);
            unsigned long long* slot = (unsigned long long*)part + ((size_t)(u.pm * BM + tid) * 8 + u.pn);
            __hip_atomic_store(slot, (unsigned long long)__float_as_uint(q), __ATOMIC_RELAXED, __HIP_MEMORY_SCOPE_AGENT); }
        xcd_barrier(bar, tid == 0);
        if (tid < 256) { const unsigned long long* slot = (const unsigned long long*)part + (size_t)(u.pm * BM + tid) * 8 + (u.pn & 2);
            const float q = __uint_as_float((unsigned)__hip_atomic_load(slot, __ATOMIC_RELAXED, __HIP_MEMORY_SCOPE_AGENT)) + __uint_as_float((unsigned)__hip_atomic_load(slot + 1, __ATOMIC_RELAXED, __HIP_MEMORY_SCOPE_AGENT));
            S[tid] = 1.0f / sqrtf(q * (1.f / 512.f) + 1e-6f); }
        asm volatile("s_waitcnt lgkmcnt(0)" ::: "memory"); __builtin_amdgcn_s_barrier(); asm volatile("" ::: "memory");
        bf16_t* O = (u.pn & 2) ? ckvn : cqn; const float* g = (u.pn & 2) ? gkv : gq;
        const int colp = (u.pn & 1) * BM + wc * 32 + 8 * fq;
        f32x4 gg[2][2];
#pragma unroll
        for (int bj = 0; bj < 2; ++bj)
#pragma unroll
            for (int n = 0; n < 2; ++n) gg[bj][n] = *(const f32x4*)(g + colp + bj * HALF + 4 * n);
#pragma unroll
        for (int ai = 0; ai < 2; ++ai)
#pragma unroll
            for (int m = 0; m < 4; ++m) { const int r = ai * HALF + wr * 64 + m * 16 + fr; const float rs = S[r]; bf16_t* rowp = O + (size_t)(u.pm * BM + r) * 512 + colp;
#pragma unroll
                for (int bj = 0; bj < 2; ++bj) *(u32x4*)(rowp + bj * HALF) = pack8bf(acc[ai][bj][m][0] * rs * gg[bj][0], acc[ai][bj][m][1] * rs * gg[bj][1]); }
    }
};
struct QuadOrder {
    int c;
    __device__ bool next(int i, Unit& u) const { if (i != 0) return false; const int x = c & 7, j = c >> 3; u.pm = x * 8 + (j & 7); u.pn = j >> 3; return true; }
    __device__ __forceinline__ void a_ready(const Unit&) const {}
    __device__ __forceinline__ void done(const Unit&) const {}
};
template <int NT>
__device__ __forceinline__ void skinny_gemm(const bf16_t* __restrict__ X, const bf16_t* __restrict__ Wt, int wrow0, int wstride, int rg, int lane, int k_lo, int k_hi, f32x4 (&acc)[NT]) {
    const int fr = lane & 15, fq = lane >> 4;
    const bf16_t* xa = X + (size_t)(rg * 16 + fr) * 2048 + 8 * fq;
    const bf16_t* wb = Wt + (size_t)(wrow0 + fr) * 2048 + 8 * fq;
#pragma unroll
    for (int nt = 0; nt < NT; ++nt) acc[nt] = (f32x4){0.f, 0.f, 0.f, 0.f};
    bf16x8 a0[4], b0[NT][4], a1[4], b1[NT][4];
#define SK_LOAD(A_, B_, k_) do { _Pragma("unroll") for (int u_ = 0; u_ < 4; ++u_) { A_[u_] = *(const bf16x8*)(xa + (k_) + 32 * u_); \
        _Pragma("unroll") for (int nt = 0; nt < NT; ++nt) B_[nt][u_] = *(const bf16x8*)(wb + (size_t)nt * wstride * 2048 + (k_) + 32 * u_); } } while (0)
#define SK_MMA(A_, B_) do { _Pragma("unroll") for (int u_ = 0; u_ < 4; ++u_) _Pragma("unroll") for (int nt = 0; nt < NT; ++nt) \
        acc[nt] = __builtin_amdgcn_mfma_f32_16x16x32_bf16(B_[nt][u_], A_[u_], acc[nt], 0, 0, 0); } while (0)
    SK_LOAD(a0, b0, k_lo);
    for (int k = k_lo; k < k_hi; k += 256) {
        SK_LOAD(a1, b1, k + 128);
        SK_MMA(a0, b0);
        if (k + 256 < k_hi) SK_LOAD(a0, b0, k + 256);
        SK_MMA(a1, b1);
    }
#undef SK_LOAD
#undef SK_MMA
}
template <class Epi, class Sched, bool ALIGN_EPI = false, bool SP2 = false>
__device__ __forceinline__ void gemm_phase(PG8_LAS unsigned char* lds, const Gemm g, const Sched& S, const Epi& E, const int wid) {
    const int lane = lane_opaque(), tid = wid * 64 + lane, wr = wid >> 2, wc = wid & 3, fr = lane & 15, fq = lane >> 4;
    const int K = g.K, nt = K / BK;
    unsigned voffA[2], voffB[2];
#pragma unroll
    for (int i = 0; i < 2; ++i) { int R, C; stage_rc(tid * 16 + i * 8192, R, C); const int Rb = Epi::PERM ? ((R & ~31) + perm32(R & 31)) : R;
        voffA[i] = (unsigned)(R * K + C) * 2u; voffB[i] = (unsigned)(Rb * K + C) * 2u; }
    const size_t kstep = (size_t)(BK * 2);
    const size_t hstep = (size_t)HALF * K * 2;
    const size_t tstep = 2 * hstep;
    const unsigned ldsw = (unsigned)wid * 1024u;
    const int aoff = lds_byte(wr * 64 + fr, fq * 8), boff = lds_byte(wc * 32 + fr, fq * 8);
#define PG8_SA(b, h) (((b) * 2 + (h)) * HTB)
#define PG8_SB(b, h) ((4 + (b) * 2 + (h)) * HTB)
#define PG8_STAGE(bufoff, gbase, voff) do { _Pragma("unroll") for (int _i = 0; _i < 2; ++_i) \
        __builtin_amdgcn_global_load_lds((const unsigned*)((const char*)(gbase) + (voff)[_i]), (PG8_LAS unsigned*)(lds + (bufoff) + ldsw + _i * 8192), 16, 0, 0); } while (0)
#define PG8_LDA(dst, b, h) do { _Pragma("unroll") for (int m = 0; m < 4; ++m) _Pragma("unroll") for (int k = 0; k < 2; ++k) dst[m][k] = *(const PG8_LAS bf16x8*)(lds + PG8_SA(b, h) + aoff + m * 2048 + k * 1024); } while (0)
#define PG8_LDB(dst, b, h) do { _Pragma("unroll") for (int n = 0; n < 2; ++n) _Pragma("unroll") for (int k = 0; k < 2; ++k) dst[n][k] = *(const PG8_LAS bf16x8*)(lds + PG8_SB(b, h) + boff + n * 2048 + k * 1024); } while (0)
#define PG8_MMA(ai, bj, At, Bt) do { __builtin_amdgcn_s_setprio(1); _Pragma("unroll") for (int m = 0; m < 4; ++m) _Pragma("unroll") for (int n = 0; n < 2; ++n) _Pragma("unroll") for (int k = 0; k < 2; ++k) \
        acc[ai][bj][m][n] = __builtin_amdgcn_mfma_f32_16x16x32_bf16(Bt[n][k], At[m][k], acc[ai][bj][m][n], 0, 0, 0); __builtin_amdgcn_s_setprio(0); } while (0)
#define PG8_WAIT_V(n) asm volatile("s_waitcnt vmcnt(" #n ")" ::: "memory")
#define PG8_WAIT_L(n) asm volatile("s_waitcnt lgkmcnt(" #n ")" ::: "memory")
#define PG8_BAR __builtin_amdgcn_s_barrier()
#define PG8_SCHED __builtin_amdgcn_sched_barrier(0)
    Unit cur, nxt; int ui = 0;
    if (!S.next(0, cur)) return;
    f32x4 acc[2][2][4][2];
#pragma unroll
    for (int a = 0; a < 2; ++a)
#pragma unroll
        for (int b = 0; b < 2; ++b)
#pragma unroll
            for (int m = 0; m < 4; ++m)
#pragma unroll
                for (int n = 0; n < 2; ++n) acc[a][b][m][n] = (f32x4){0.f, 0.f, 0.f, 0.f};
    bf16x8 At[4][2], B0[2][2], B1[2][2];
    const char* cA = (const char*)g.A + (size_t)cur.pm * tstep; const char* cB = (const char*)g.Bt + (size_t)cur.pn * tstep;
    S.a_ready(cur);
    if constexpr (SP2) {
        PG8_STAGE(PG8_SB(0, 0), cB, voffB); PG8_STAGE(PG8_SB(0, 1), cB + hstep, voffB); PG8_STAGE(PG8_SA(0, 0), cA, voffA); PG8_STAGE(PG8_SA(0, 1), cA + hstep, voffA);
        if (wr == 1) PG8_BAR;
        PG8_WAIT_V(2); PG8_BAR;
        PG8_STAGE(PG8_SB(1, 0), cB + kstep, voffB); PG8_STAGE(PG8_SA(1, 0), cA + kstep, voffA); PG8_STAGE(PG8_SB(1, 1), cB + hstep + kstep, voffB);
        PG8_WAIT_V(6); PG8_BAR;
    } else {
        PG8_STAGE(PG8_SB(0, 0), cB, voffB); PG8_STAGE(PG8_SA(0, 0), cA, voffA); PG8_STAGE(PG8_SB(0, 1), cB + hstep, voffB); PG8_STAGE(PG8_SA(0, 1), cA + hstep, voffA);
        if (wr == 1) PG8_BAR;
        PG8_WAIT_V(4); PG8_BAR;
        PG8_STAGE(PG8_SB(1, 0), cB + kstep, voffB); PG8_STAGE(PG8_SA(1, 0), cA + kstep, voffA); PG8_STAGE(PG8_SB(1, 1), cB + hstep + kstep, voffB);
        PG8_WAIT_V(6); PG8_BAR;
    }
    for (;;) {
        const bool has_next = S.next(ui + 1, nxt);
        const char* nA = has_next ? (const char*)g.A + (size_t)nxt.pm * tstep : cA; const char* nB = has_next ? (const char*)g.Bt + (size_t)nxt.pn * tstep : cB;
        for (int t = 0; t < nt; t += 2) {
            const bool last = (t == nt - 2);
            const char* a1 = cA + (size_t)(t + 1) * kstep;
            const char* a2 = last ? nA : cA + (size_t)(t + 2) * kstep; const char* b2 = last ? nB : cB + (size_t)(t + 2) * kstep;
            const char* a3 = a2 + kstep; const char* b3 = b2 + kstep;
            if (last && has_next) S.a_ready(nxt);
            if constexpr (SP2) {
            PG8_LDB(B0, 0, 0); PG8_LDB(B1, 0, 1); PG8_SCHED; PG8_LDA(At, 0, 0); PG8_STAGE(PG8_SA(1, 1), a1 + hstep, voffA);
            PG8_WAIT_V(8); PG8_WAIT_L(0); PG8_BAR; PG8_MMA(0, 0, At, B0); PG8_MMA(0, 1, At, B1); PG8_BAR; PG8_SCHED;
            PG8_LDA(At, 0, 1); PG8_STAGE(PG8_SB(0, 0), b2, voffB); PG8_STAGE(PG8_SB(0, 1), b2 + hstep, voffB); PG8_STAGE(PG8_SA(0, 0), a2, voffA);
            PG8_WAIT_V(8); PG8_WAIT_L(0); PG8_BAR; PG8_MMA(1, 0, At, B0); PG8_MMA(1, 1, At, B1); PG8_BAR; PG8_SCHED;
            PG8_LDB(B0, 1, 0); PG8_LDB(B1, 1, 1); PG8_SCHED; PG8_LDA(At, 1, 0); PG8_STAGE(PG8_SA(0, 1), a2 + hstep, voffA);
            PG8_WAIT_V(8); PG8_WAIT_L(0); PG8_BAR; PG8_MMA(0, 0, At, B0); PG8_MMA(0, 1, At, B1); PG8_BAR; PG8_SCHED;
            PG8_LDA(At, 1, 1); PG8_STAGE(PG8_SB(1, 0), b3, voffB); PG8_STAGE(PG8_SB(1, 1), b3 + hstep, voffB); PG8_STAGE(PG8_SA(1, 0), a3, voffA);
            PG8_WAIT_V(8); PG8_WAIT_L(0); PG8_BAR; PG8_MMA(1, 0, At, B0); PG8_MMA(1, 1, At, B1); PG8_BAR; PG8_SCHED;
            } else {
            PG8_LDB(B0, 0, 0); PG8_SCHED; PG8_LDA(At, 0, 0); PG8_STAGE(PG8_SA(1, 1), a1 + hstep, voffA);
            PG8_WAIT_L(8); PG8_BAR; PG8_WAIT_L(0); PG8_MMA(0, 0, At, B0); PG8_BAR; PG8_SCHED;
            PG8_LDB(B1, 0, 1); PG8_STAGE(PG8_SB(0, 0), b2, voffB);
            PG8_BAR; PG8_WAIT_L(0); PG8_MMA(0, 1, At, B1); PG8_BAR;
            PG8_LDA(At, 0, 1); PG8_STAGE(PG8_SA(0, 0), a2, voffA);
            PG8_BAR; PG8_WAIT_L(0); PG8_MMA(1, 0, At, B0); PG8_BAR; PG8_SCHED;
            PG8_STAGE(PG8_SB(0, 1), b2 + hstep, voffB);
            PG8_WAIT_V(6); PG8_BAR; PG8_MMA(1, 1, At, B1); PG8_BAR;
            PG8_LDB(B0, 1, 0); PG8_SCHED; PG8_LDA(At, 1, 0); PG8_STAGE(PG8_SA(0, 1), a2 + hstep, voffA);
            PG8_WAIT_L(8); PG8_BAR; PG8_WAIT_L(0); PG8_MMA(0, 0, At, B0); PG8_BAR; PG8_SCHED;
            PG8_LDB(B1, 1, 1); PG8_STAGE(PG8_SB(1, 0), b3, voffB);
            PG8_BAR; PG8_WAIT_L(0); PG8_MMA(0, 1, At, B1); PG8_BAR;
            PG8_LDA(At, 1, 1); PG8_STAGE(PG8_SA(1, 0), a3, voffA);
            PG8_BAR; PG8_WAIT_L(0); PG8_MMA(1, 0, At, B0); PG8_BAR; PG8_SCHED;
            PG8_STAGE(PG8_SB(1, 1), b3 + hstep, voffB);
            PG8_WAIT_V(6); PG8_BAR; PG8_MMA(1, 1, At, B1); PG8_BAR;
            }
        }
        if constexpr (ALIGN_EPI) { if (wr == 0) PG8_BAR; }
        if constexpr (!Epi::AFTER_DRAIN) { E(acc, cur, wr, wc, fr, fq);
#ifdef XEPI2
            for (int q_ = 0; q_ < XEPI2; ++q_) { asm volatile("" ::: "memory"); E(acc, cur, wr, wc, fr, fq); }
#endif
            S.done(cur); }
        if (!has_next) break;
#pragma unroll
        for (int a = 0; a < 2; ++a)
#pragma unroll
            for (int b = 0; b < 2; ++b)
#pragma unroll
                for (int m = 0; m < 4; ++m)
#pragma unroll
                    for (int n = 0; n < 2; ++n) acc[a][b][m][n] = (f32x4){0.f, 0.f, 0.f, 0.f};
        cur = nxt; cA = nA; cB = nB; ++ui;
        if constexpr (ALIGN_EPI) { if (wr == 1) PG8_BAR; }
    }
    PG8_WAIT_V(0);
    if constexpr (!ALIGN_EPI) { if (wr == 0) PG8_BAR; }
    PG8_BAR;
    if constexpr (Epi::AFTER_DRAIN) { E.fused(acc, cur, wr, wc, fr, fq, lds, wid, lane); S.done(cur); }
#undef PG8_SA
#undef PG8_SB
#undef PG8_STAGE
#undef PG8_LDA
#undef PG8_LDB
#undef PG8_MMA
#undef PG8_WAIT_V
#undef PG8_WAIT_L
#undef PG8_BAR
#undef PG8_SCHED
}
}
namespace att {
using bf16 = __hip_bfloat16;
typedef short bf16x8 __attribute__((ext_vector_type(8)));
typedef short s16x4 __attribute__((ext_vector_type(4)));
typedef float f32x16 __attribute__((ext_vector_type(16)));
typedef float f32x4 __attribute__((ext_vector_type(4)));
typedef unsigned u32x4 __attribute__((ext_vector_type(4)));
template <class A, class Bt> struct same_t { static constexpr bool v = false; };
template <class A> struct same_t<A, A> { static constexpr bool v = true; };

#define KSWZ(row, colB) ((row) * 256 + ((colB) ^ (((row) & 7) << 4)))
#define SBAR() __builtin_amdgcn_sched_barrier(0)
__device__ __forceinline__ int v_st(int k, int c) { const int kk = (k & ~0xC) | ((k & 4) << 1) | ((k & 8) >> 1); return ((kk >> 3) * 4 + (c >> 5)) * 512 + ((kk & 7) * 32 + (c & 31)) * 2; }
__device__ __forceinline__ int v_rd_base(int lane) { return ((lane & 3) << 3) | (((lane >> 2) & 3) << 6) | (((lane >> 4) & 1) << 5) | (((lane >> 5) & 1) << 8); }
constexpr int v_rd_off(int d0, int ks, int half) { return d0 * 512 + ks * 4096 + half * 2048; }
__device__ __forceinline__ int crow(int r, int hi) { return (r & 3) + 8 * (r >> 2) + 4 * hi; }
__device__ __forceinline__ unsigned cvtpk(float lo, float hi) {
    unsigned r; asm volatile("v_cvt_pk_bf16_f32 %0, %1, %2" : "=v"(r) : "v"(lo), "v"(hi)); return r;
}
__device__ __forceinline__ bf16x8 pack8(f32x4 a, f32x4 b) {
    u32x4 w = {cvtpk(a[0], a[1]), cvtpk(a[2], a[3]), cvtpk(b[0], b[1]), cvtpk(b[2], b[3])};
    return *reinterpret_cast<bf16x8*>(&w);
}
template <class T> __device__ __forceinline__ bf16x8 load8(const T* p) {
    if constexpr (same_t<T, float>::v) { return pack8(*(const f32x4*)p, *(const f32x4*)(p + 4)); }
    else { return *reinterpret_cast<const bf16x8*>(p); }
}
__device__ __forceinline__ void mask_tile(f32x16& p0, f32x16& p1, int dq, unsigned W) {
    const float NEG = -__builtin_inff();
#pragma unroll
    for (int r = 0; r < 16; ++r) {
        const int c = (r & 3) + 8 * (r >> 2);
        if ((unsigned)(dq - c) >= W) p0[r] = NEG;
        if ((unsigned)(dq - c - 32) >= W) p1[r] = NEG;
    }
}
constexpr int SHM_V = 16384;
template <int DQK> struct ACfg { static constexpr float SCALE = DQK == 192 ? 0.07216878364870323f : 0.08838834764831845f; };
constexpr float THR = 8.f;
template <int DQK>
__device__ __forceinline__ void partialSM(f32x16& p0, f32x16& p1, float& m_reg, float& mn, float& alpha) {
    constexpr float SCALE = ACfg<DQK>::SCALE;
    float pmax = p0[0]; for (int r = 1; r < 16; ++r) pmax = fmaxf(pmax, p0[r]); for (int r = 0; r < 16; ++r) pmax = fmaxf(pmax, p1[r]);
    { auto rr = __builtin_amdgcn_permlane32_swap(__float_as_uint(pmax), __float_as_uint(pmax), false, false);
      pmax = fmaxf(__uint_as_float(rr[0]), __uint_as_float(rr[1])); }
    constexpr float C2 = 1.4426950408889634f * SCALE;
    if (__builtin_expect(__all((pmax - m_reg) * SCALE <= THR), 1)) { mn = m_reg; alpha = 1.f; }
    else { mn = fmaxf(m_reg, pmax); alpha = __builtin_amdgcn_exp2f((m_reg - mn) * C2); m_reg = mn; }
    const float mnL = -mn * C2;
    for (int r = 0; r < 16; ++r) p0[r] = fmaf(p0[r], C2, mnL); for (int r = 0; r < 16; ++r) p1[r] = fmaf(p1[r], C2, mnL);
    for (int r = 0; r < 16; ++r) p0[r] = __builtin_amdgcn_exp2f(p0[r]);
}
template <int DQK, bool FOX>
__device__ __forceinline__ void qkt(f32x16& p0, f32x16& p1, const char* kl, const float* cb  , int r32, int hi, const bf16x8* qr) {
    if constexpr (FOX) {
#pragma unroll
        for (int i = 0; i < 4; ++i) { const f32x4 a = *(const f32x4*)(cb + 8 * i), b = *(const f32x4*)(cb + 32 + 8 * i);
            p0[4 * i] = a[0]; p0[4 * i + 1] = a[1]; p0[4 * i + 2] = a[2]; p0[4 * i + 3] = a[3];
            p1[4 * i] = b[0]; p1[4 * i + 1] = b[1]; p1[4 * i + 2] = b[2]; p1[4 * i + 3] = b[3]; }
    } else { p0 = f32x16{}; p1 = f32x16{}; }
    const char* krow = kl + r32 * 256; const int x16 = (r32 & 15) << 4;
#pragma unroll
    for (int d0 = 0; d0 < 8; ++d0) { const char* a = krow + (((d0 * 2 + hi) << 4) ^ x16);
        bf16x8 b0 = *reinterpret_cast<const bf16x8*>(a);
        bf16x8 b1 = *reinterpret_cast<const bf16x8*>(a + 32 * 256);
        p0 = __builtin_amdgcn_mfma_f32_32x32x16_bf16(b0, qr[d0], p0, 0, 0, 0);
        p1 = __builtin_amdgcn_mfma_f32_32x32x16_bf16(b1, qr[d0], p1, 0, 0, 0); }
    if constexpr (DQK == 192) {
        const char* rrow = kl + 16384 + r32 * 128; const int x8 = ((r32 >> 1) & 7) << 4;
#pragma unroll
        for (int d0 = 0; d0 < 4; ++d0) { const char* a = rrow + (((d0 * 2 + hi) << 4) ^ x8);
            bf16x8 b0 = *reinterpret_cast<const bf16x8*>(a);
            bf16x8 b1 = *reinterpret_cast<const bf16x8*>(a + 32 * 128);
            p0 = __builtin_amdgcn_mfma_f32_32x32x16_bf16(b0, qr[8 + d0], p0, 0, 0, 0);
            p1 = __builtin_amdgcn_mfma_f32_32x32x16_bf16(b1, qr[8 + d0], p1, 0, 0, 0); }
    }
}

__device__ __forceinline__ void pv_tile_d0(f32x16* o, int vb0, bf16x8 pa0, bf16x8 pa1, bf16x8 pa2, bf16x8 pa3) {
#define TRRD(dst, off) asm volatile("ds_read_b64_tr_b16 %0, %1 offset:%2" : "=&v"(dst) : "v"(vb0), "i"(off) : "memory")
#define PV_D0(d0) do { s16x4 l0, l1, l2, l3, h0, h1, h2, h3; constexpr int b_ = (d0) * 512;   \
        TRRD(l0, b_); TRRD(h0, b_ + 2048); TRRD(l1, b_ + 4096); TRRD(h1, b_ + 6144); TRRD(l2, b_ + 8192); TRRD(h2, b_ + 10240); TRRD(l3, b_ + 12288); TRRD(h3, b_ + 14336); \
        asm volatile("s_waitcnt lgkmcnt(0)" ::: "memory"); SBAR();   \
        o[d0] = __builtin_amdgcn_mfma_f32_32x32x16_bf16(pa0, (bf16x8){l0[0], l0[1], l0[2], l0[3], h0[0], h0[1], h0[2], h0[3]}, o[d0], 0, 0, 0);   \
        o[d0] = __builtin_amdgcn_mfma_f32_32x32x16_bf16(pa1, (bf16x8){l1[0], l1[1], l1[2], l1[3], h1[0], h1[1], h1[2], h1[3]}, o[d0], 0, 0, 0);   \
        o[d0] = __builtin_amdgcn_mfma_f32_32x32x16_bf16(pa2, (bf16x8){l2[0], l2[1], l2[2], l2[3], h2[0], h2[1], h2[2], h2[3]}, o[d0], 0, 0, 0);   \
        o[d0] = __builtin_amdgcn_mfma_f32_32x32x16_bf16(pa3, (bf16x8){l3[0], l3[1], l3[2], l3[3], h3[0], h3[1], h3[2], h3[3]}, o[d0], 0, 0, 0); } while (0)
    PV_D0(0); PV_D0(1); PV_D0(2); PV_D0(3);
#undef PV_D0
#undef TRRD
}
__device__ __forceinline__ void finishSM(f32x16& p0, f32x16& p1, float alpha, float& l_reg, bf16x8& pa0, bf16x8& pa1, bf16x8& pa2, bf16x8& pa3) {
    for (int r = 0; r < 16; ++r) p1[r] = __builtin_amdgcn_exp2f(p1[r]);
    float ps = 0; for (int r = 0; r < 16; ++r) ps += p0[r]; for (int r = 0; r < 16; ++r) ps += p1[r];
    { auto rr = __builtin_amdgcn_permlane32_swap(__float_as_uint(ps), __float_as_uint(ps), false, false);
      ps = __uint_as_float(rr[0]) + __uint_as_float(rr[1]); }
    l_reg = l_reg * alpha + ps;
#define PK4(P, B_, OUT) do { unsigned a0 = cvtpk(P[B_+0], P[B_+1]), a1 = cvtpk(P[B_+2], P[B_+3]);                          \
        unsigned b0 = cvtpk(P[B_+4], P[B_+5]), b1 = cvtpk(P[B_+6], P[B_+7]);                                             \
        auto r0 = __builtin_amdgcn_permlane32_swap(a0, b0, false, false); auto r1 = __builtin_amdgcn_permlane32_swap(a1, b1, false, false); \
        u32x4 w = {r0[0], r1[0], r0[1], r1[1]}; OUT = *reinterpret_cast<bf16x8*>(&w); } while (0)
    PK4(p0, 0, pa0); PK4(p0, 8, pa1); PK4(p1, 0, pa2); PK4(p1, 8, pa3);
#undef PK4
}
__device__ __forceinline__ void pv_tile(f32x16* o, int vb0  , bf16x8 pa0, bf16x8 pa1, bf16x8 pa2, bf16x8 pa3) {
#define TRRD(dst, off) asm volatile("ds_read_b64_tr_b16 %0, %1 offset:%2" : "=&v"(dst) : "v"(vb0), "i"(off) : "memory")
#define PV_RD(L, H, ks) do { constexpr int b_ = (ks) * 4096; TRRD(L[0], b_); TRRD(H[0], b_ + 2048); TRRD(L[1], b_ + 512); TRRD(H[1], b_ + 512 + 2048); \
        TRRD(L[2], b_ + 1024); TRRD(H[2], b_ + 1024 + 2048); TRRD(L[3], b_ + 1536); TRRD(H[3], b_ + 1536 + 2048); } while (0)
#define PV_MM(L, H, pa) do { _Pragma("unroll") for (int d0 = 0; d0 < 4; ++d0) \
        o[d0] = __builtin_amdgcn_mfma_f32_32x32x16_bf16(pa, (bf16x8){L[d0][0], L[d0][1], L[d0][2], L[d0][3], H[d0][0], H[d0][1], H[d0][2], H[d0][3]}, o[d0], 0, 0, 0); } while (0)
#define PV_WAIT(n) do { asm volatile("s_waitcnt lgkmcnt(" #n ")" ::: "memory"); SBAR(); } while (0)
    s16x4 la[4], ha[4], lb[4], hb[4];
    PV_RD(la, ha, 0); PV_RD(lb, hb, 1);
    PV_WAIT(8); PV_MM(la, ha, pa0); SBAR();
    PV_RD(la, ha, 2);
    PV_WAIT(8); PV_MM(lb, hb, pa1); SBAR();
    PV_RD(lb, hb, 3);
    PV_WAIT(8); PV_MM(la, ha, pa2); SBAR();
    PV_WAIT(0); PV_MM(lb, hb, pa3);
#undef PV_RD
#undef PV_MM
#undef PV_WAIT
#undef TRRD
}
constexpr int SEQ = 4096, NHEAD = 16, TOKP = 2048;
template <int DQK, bool FOX>
__device__ __forceinline__ void attn_phase(char* lds, LAS unsigned char* ldsl, const bf16* __restrict__ Q, const bf16* __restrict__ Kn, const bf16* __restrict__ Kr, const bf16* __restrict__ V,
                                           bf16* __restrict__ O, const float* __restrict__ logf, int G, int bid, const int wid) {
    constexpr int QP = NHEAD * DQK;
    constexpr int SLOT = DQK == 192 ? 40960 : 32768;
    constexpr int VOFF = DQK == 192 ? 24576 : 16384;
    constexpr bool PIPE = FOX;
    constexpr int KSZ = SLOT - 16384, VRING = 3 * KSZ;
    const int lane = lane_opaque(), tid = wid * 64 + lane, r32 = lane & 31, hi = lane >> 5;
    float* wsb = (float*)(lds + 3 * SLOT); float* ws = wsb + wid * 64; float* li_l = ws; float* al_l = ws + 32;
    float* Cb = wsb + 8 * 64;
    float* scn = Cb + 4096;
    unsigned koff0, koff1, voff0, voff1, roff;
    { const int q0 = wid * 128 + lane, q1 = q0 + 64;
      { const int row = q0 >> 4, src = (q0 & 15) ^ (row & 15); koff0 = (unsigned)(row * TOKP + src * 8) * 2u; }
      { const int row = q1 >> 4, src = (q1 & 15) ^ (row & 15); koff1 = (unsigned)(row * TOKP + src * 8) * 2u; }
      { const int s = q0 >> 5, w = q0 & 31, kk = (s >> 2) * 8 + (w >> 2), c = (s & 3) * 32 + (w & 3) * 8, k = (kk & ~0xC) | ((kk & 4) << 1) | ((kk & 8) >> 1); voff0 = (unsigned)(k * TOKP + c) * 2u; }
      { const int s = q1 >> 5, w = q1 & 31, kk = (s >> 2) * 8 + (w >> 2), c = (s & 3) * 32 + (w & 3) * 8, k = (kk & ~0xC) | ((kk & 4) << 1) | ((kk & 8) >> 1); voff1 = (unsigned)(k * TOKP + c) * 2u; }
      { const int q = wid * 64 + lane, row = q >> 3, src = (q & 7) ^ ((row >> 1) & 7); roff = (unsigned)(row * 64 + src * 8) * 2u; } }
    const int vrd = (int)(uintptr_t)lds + VOFF + v_rd_base(lane);
#define A_GLDS(gp_, lp_) __builtin_amdgcn_global_load_lds((const unsigned*)(gp_), (LAS unsigned*)(lp_), 16, 0, 0)
#define A_DMA(kb_, slot_) do { LAS unsigned char* d_ = ldsl + (slot_) * SLOT + wid * 2048; const char* kg_ = (const char*)(Kh + (size_t)(kb_) * TOKP); const char* vg_ = (const char*)(Vh + (size_t)(kb_) * TOKP); \
        A_GLDS(kg_ + koff0, d_); A_GLDS(kg_ + koff1, d_ + 1024);                                                        \
        if constexpr (DQK == 192) A_GLDS((const char*)(Krh + (size_t)(kb_) * 64) + roff, ldsl + (slot_) * SLOT + 16384 + wid * 1024); \
        A_GLDS(vg_ + voff0, d_ + VOFF); A_GLDS(vg_ + voff1, d_ + VOFF + 1024); } while (0)
#define A_DMAK(kb_, slot_) do { LAS unsigned char* d_ = ldsl + (slot_) * KSZ + wid * 2048; const char* kg_ = (const char*)(Kh + (size_t)(kb_) * TOKP);       \
        A_GLDS(kg_ + koff0, d_); A_GLDS(kg_ + koff1, d_ + 1024);                                                        \
        if constexpr (DQK == 192) A_GLDS((const char*)(Krh + (size_t)(kb_) * 64) + roff, ldsl + (slot_) * KSZ + 16384 + wid * 1024); } while (0)
#define A_DMAV(kb_, slot_) do { LAS unsigned char* d_ = ldsl + VRING + (slot_) * 16384 + wid * 2048; const char* vg_ = (const char*)(Vh + (size_t)(kb_) * TOKP); \
        A_GLDS(vg_ + voff0, d_); A_GLDS(vg_ + voff1, d_ + 1024); } while (0)
#define A_BAR() do { asm volatile("s_waitcnt lgkmcnt(0)" ::: "memory"); __builtin_amdgcn_s_barrier(); asm volatile("" ::: "memory"); } while (0)
#define A_VMW(n) do { if constexpr (DQK == 192) { if ((n) == 1) asm volatile("s_waitcnt vmcnt(5)" ::: "memory"); else asm volatile("s_waitcnt vmcnt(0)" ::: "memory"); } \
                      else { if ((n) == 1) asm volatile("s_waitcnt vmcnt(4)" ::: "memory"); else asm volatile("s_waitcnt vmcnt(0)" ::: "memory"); } } while (0)
    for (int L = bid; L < 512; L += G) {
        const int xcd = L & 7, idx = L >> 3, bh = xcd + 8 * (idx >> 3), x = idx & 7, b = bh >> 4, h = bh & 15;
        const size_t row0 = (size_t)b * SEQ;
        const bf16* Kh = Kn + row0 * TOKP + h * 128; const bf16* Vh = V + row0 * TOKP + h * 128; const bf16* Krh = Kr + row0 * 64;
        for (int pass = 0; pass < 2; ++pass) {
            const int qb = pass ? 15 - x : x, P0 = qb * 256, NT = P0 / 64 + 4;
            __syncthreads();
            if constexpr (PIPE) { A_DMAK(0, 0); A_DMAK(64, 1); A_DMAV(0, 0); A_DMAK(128, 2); A_DMAV(64, 1); }
            else { A_DMA(0, 0); A_DMA(64, 1); }
            if constexpr (FOX) {
                float v[8]; float s = 0.f; int k0 = tid * 8; asm volatile("" : "+v"(k0)); const bool on = k0 < P0 + 256;
#pragma unroll
                for (int j = 0; j < 8; ++j) { v[j] = on ? logf[(row0 + k0 + j) * 16 + h] : 0.f; }
#pragma unroll
                for (int j = 0; j < 8; ++j) { s += v[j]; v[j] = s; }
                float inc = s;
#pragma unroll
                for (int o_ = 1; o_ < 64; o_ <<= 1) { const float t_ = __shfl_up(inc, o_); if (lane >= o_) inc += t_; }
                if (lane == 63) scn[wid] = inc;
                __syncthreads();
                float base = inc - s;
                for (int w_ = 0; w_ < wid; ++w_) base += scn[w_];
                if (on) {
#pragma unroll
                    for (int j = 0; j < 8; ++j) Cb[k0 + j] = -(base + v[j]) * 11.313708498984761f;
                }
            }
            bf16x8 qr[DQK / 16];
            { int qoff = r32 * QP + hi * 8; asm volatile("" : "+v"(qoff));
              const bf16* qp = Q + (row0 + P0 + wid * 32) * QP + h * DQK + qoff;
#pragma unroll
              for (int d0 = 0; d0 < DQK / 16; ++d0) qr[d0] = *reinterpret_cast<const bf16x8*>(qp + d0 * 16); }
            asm volatile("s_waitcnt vmcnt(0)" ::: "memory");
#pragma unroll
            for (int d0 = 0; d0 < DQK / 16; ++d0) asm volatile("" : "+v"(qr[d0]));
            A_BAR();
            const int qlo = P0 + wid * 32, qloE = FOX ? qlo : (qlo | 63), qhiE = FOX ? qlo + 31 : (qlo | 63), qm = (FOX ? (qlo + r32) : ((qlo + r32) | 63)) - 4 * hi;
            float m_reg = -1e30f, l_reg = 0.f; f32x16 o[4] = {};
            f32x16 p0, p1; float mn, alpha; bf16x8 pa0, pa1, pa2, pa3;
#define A_RESC(a) do { if (__any((a) < 1.f)) { if (hi == 0) al_l[r32] = (a); asm volatile("s_waitcnt lgkmcnt(0)" ::: "memory");              \
                     for (int d_ = 0; d_ < 4; ++d_) for (int r = 0; r < 16; ++r) o[d_][r] *= al_l[crow(r, hi)]; } } while (0)
            if constexpr (PIPE) {
                const int vrp = (int)(uintptr_t)lds + VRING + v_rd_base(lane);
                f32x16 q0, q1; float alP, alQ;
                SBAR(); qkt<DQK, FOX>(p0, p1, lds, Cb + 4 * hi, r32, hi, qr); SBAR();
                if (63 > qloE) mask_tile(p0, p1, qm, 1u << 30);
                partialSM<DQK>(p0, p1, m_reg, mn, alP); SBAR();
                int s0 = 0, s1 = 1, s2 = 2;
#define A_PSTEP(t, LAST, PX0, PX1, alX, PY0, PY1, alY) do { const int kb_ = (t) * 64;                                      \
                    SBAR(); if (!(LAST)) qkt<DQK, FOX>(PY0, PY1, lds + s1 * KSZ, Cb + kb_ + 64 + 4 * hi, r32, hi, qr);     \
                    finishSM(PX0, PX1, alX, l_reg, pa0, pa1, pa2, pa3); SBAR();                                            \
                    { const int k3_ = ((t) + 3 < NT ? (t) + 3 : NT - 1) * 64, v2_ = ((t) + 2 < NT ? (t) + 2 : NT - 1) * 64; A_DMAK(k3_, s0); A_DMAV(v2_, s2); }   \
                    SBAR(); pv_tile_d0(o, vrp + s0 * 16384, pa0, pa1, pa2, pa3); SBAR();                                   \
                    if (!(LAST)) { if (kb_ + 127 > qloE) mask_tile(PY0, PY1, qm - kb_ - 64, 1u << 30);                     \
                        partialSM<DQK>(PY0, PY1, m_reg, mn, alY); A_RESC(alY); SBAR(); }                                   \
                    A_VMW(1); A_BAR();                                                                                     \
                    { const int t_ = s0; s0 = s1; s1 = s2; s2 = t_; } } while (0)
#pragma unroll 1
                for (int t = 0; t < NT - 2; t += 2) { A_PSTEP(t, false, p0, p1, alP, q0, q1, alQ); A_PSTEP(t + 1, false, q0, q1, alQ, p0, p1, alP); }
                A_PSTEP(NT - 2, false, p0, p1, alP, q0, q1, alQ); A_PSTEP(NT - 1, true, q0, q1, alQ, p0, p1, alP);
#undef A_PSTEP
            } else {
            int sc = 0, s2 = 2;
#pragma unroll 1
            for (int t = 0; t < NT; ++t) { const int kb_ = t * 64; const int kn_ = (t + 2 < NT ? t + 2 : NT - 1) * 64;
                const bool act_ = kb_ <= qhiE;
                if (act_) { SBAR(); qkt<DQK, FOX>(p0, p1, lds + sc * SLOT, Cb + kb_ + 4 * hi, r32, hi, qr); SBAR(); }
                A_DMA(kn_, s2);
                SBAR();
                if (act_) { if (kb_ + 63 > qloE) mask_tile(p0, p1, qm - kb_, 1u << 30);
                    partialSM<DQK>(p0, p1, m_reg, mn, alpha); finishSM(p0, p1, alpha, l_reg, pa0, pa1, pa2, pa3);
                    A_RESC(alpha); SBAR();
                    pv_tile(o, vrd + sc * SLOT, pa0, pa1, pa2, pa3); SBAR(); }
                A_VMW(1);
                A_BAR();
                sc = sc == 2 ? 0 : sc + 1; s2 = s2 == 2 ? 0 : s2 + 1; }
            }
            A_VMW(0);
            if (hi == 0) li_l[r32] = l_reg; asm volatile("s_waitcnt lgkmcnt(0)" ::: "memory");
            bf16* Ow = O + (row0 + P0 + wid * 32) * TOKP + h * 128;
            int obase = hi * 4 * TOKP + r32; asm volatile("" : "+v"(obase));
#pragma unroll
            for (int r = 0; r < 16; ++r) { const int orow = (r & 3) + 8 * (r >> 2); const float rl = __builtin_amdgcn_rcpf(li_l[orow + 4 * hi]);
#pragma unroll
                for (int d0 = 0; d0 < 4; ++d0) { const float v = o[d0][r] * rl; const float vn = __shfl_xor(v, 1);
                    if ((r32 & 1) == 0) *(unsigned*)(Ow + obase + orow * TOKP + d0 * 32) = cvtpk(v, vn); } }
#undef A_RESC
        }
    }
#undef A_GLDS
#undef A_DMA
#undef A_DMAK
#undef A_DMAV
#undef A_BAR
#undef A_VMW
}
#undef SBAR
}
typedef unsigned short bf16_t;
typedef float f32x4 __attribute__((ext_vector_type(4)));
typedef unsigned u32x4 __attribute__((ext_vector_type(4)));
typedef unsigned u32x2 __attribute__((ext_vector_type(2)));
constexpr int M = 16384, DM = 2048, FFH = 5632, NPH = 17;
constexpr float ALPHA = 1.4142135623730951f;
constexpr size_t MiB = 1u << 20;
constexpr size_t WS_WIN0 = 1 * MiB, WS_WQUP = 6 * MiB, WS_WKVUP = 9 * MiB, WS_WO0 = 13 * MiB, WS_WIN1 = 21 * MiB, WS_WO1 = 46 * MiB,
                 WS_WGU0 = 54 * MiB, WS_WGU1 = 98 * MiB, WS_WDN0 = 142 * MiB, WS_WDN1 = 164 * MiB, WS_TAB = 186 * MiB, WS_LOGF = 190 * MiB,
                 WS_PART = 191 * MiB, WS_XB = 192 * MiB, WS_R = 256 * MiB;
constexpr size_t WS_Q = WS_R, WS_H0 = WS_R, WS_K = WS_R + 96 * MiB, WS_V = WS_R + 160 * MiB, WS_O = WS_R + 224 * MiB, WS_CQN = WS_R + 288 * MiB, WS_CKVN = WS_R + 304 * MiB, WS_KROPE = WS_R + 320 * MiB;
constexpr size_t WS_FQ = WS_R, WS_FK = WS_R + 64 * MiB, WS_FV = WS_R + 128 * MiB, WS_HFF = WS_R;
constexpr int LDS_BYTES = 147456;
#ifndef GALIGN
#define GALIGN true
#endif
#ifndef GSP2
#define GSP2 true
#endif

__device__ __forceinline__ unsigned cvtpk2(float lo, float hi) { unsigned r; asm volatile("v_cvt_pk_bf16_f32 %0, %1, %2" : "=v"(r) : "v"(lo), "v"(hi)); return r; }
__device__ __forceinline__ float wave_sum(float v) {
#pragma unroll
    for (int o = 1; o < 64; o <<= 1) v += __shfl_xor(v, o);
    return v;
}
__device__ __forceinline__ void transpose_item(const float* __restrict__ W, int K, int nsrc, int ndst, bf16_t* __restrict__ WT, LAS float* scr, int item, int lane, int kind) {
    const int nblk = ndst / 64, kb = item / nblk, nb = item - kb * nblk, k0 = 64 * kb, n0 = 64 * nb;
    int src0 = n0; bool ropeblk = false;
    if (kind == 2) { const int t = n0 >> 8, bj = (n0 >> 7) & 1, j = n0 & 127; src0 = bj * FFH + t * 128 + j; }
    if (kind == 1) ropeblk = (n0 % 192) == 128;
    const int nn = (lane & 15) * 4; const bool valid = src0 + nn < nsrc;
    int pc[4];
#pragma unroll
    for (int e = 0; e < 4; ++e) { const int j = nn + e; pc[e] = ropeblk ? (j < 32 ? 2 * j : 2 * (j - 32) + 1) : j; }
    f32x4 v[16];
#pragma unroll
    for (int i = 0; i < 16; ++i) { const int kk = 4 * i + (lane >> 4); v[i] = (f32x4){0.f, 0.f, 0.f, 0.f};
        if (valid) v[i] = *(const f32x4*)(W + (size_t)(k0 + kk) * nsrc + src0 + nn); }
#pragma unroll
    for (int i = 0; i < 16; ++i) { const int kk = 4 * i + (lane >> 4);
        scr[kk * 65 + pc[0]] = v[i][0]; scr[kk * 65 + pc[1]] = v[i][1]; scr[kk * 65 + pc[2]] = v[i][2]; scr[kk * 65 + pc[3]] = v[i][3]; }
    asm volatile("s_waitcnt lgkmcnt(0)" ::: "memory");
    const int c = lane & 7;
#pragma unroll
    for (int j = 0; j < 8; ++j) { const int n = (lane >> 3) + 8 * j; const LAS float* s = scr + (8 * c) * 65 + n;
        u32x4 o; o.x = cvtpk2(s[0 * 65], s[1 * 65]); o.y = cvtpk2(s[2 * 65], s[3 * 65]); o.z = cvtpk2(s[4 * 65], s[5 * 65]); o.w = cvtpk2(s[6 * 65], s[7 * 65]);
        *(u32x4*)(WT + (size_t)(n0 + n) * K + k0 + 8 * c) = o; }
    asm volatile("s_waitcnt lgkmcnt(0)" ::: "memory");
}
__device__ const float INV_FREQ[32] = {1.0f, 0.7498942017555237f, 0.5623413324356079f, 0.4216965138912201f, 0.3162277638912201f, 0.23713737726211548f, 0.17782793939113617f, 0.1333521455526352f, 0.10000000149011612f, 0.0749894231557846f, 0.05623413249850273f, 0.04216964915394783f, 0.03162277489900589f, 0.023713737726211548f, 0.017782794311642647f, 0.013335213996469975f, 0.009999999776482582f, 0.007498942315578461f, 0.005623413249850273f, 0.0042169648222625256f, 0.003162277629598975f, 0.0023713738191872835f, 0.0017782794311642647f, 0.0013335214462131262f, 0.0010000000474974513f, 0.0007498941849917173f, 0.000562341301701963f, 0.0004216965171508491f, 0.0003162277571391314f, 0.00023713737027719617f, 0.00017782794020604342f, 0.0001333521504420787f};

struct Args { const float* in[17]; const int* pos; float* out; unsigned char* ws; int ph_lo, ph_hi; };

__device__ __forceinline__ void phase_prep(const Args& a, unsigned char* ws, LAS unsigned char* ldsl, int bid, int G, int tid, int wid, int lane) {
    LAS float* scr = (LAS float*)(ldsl + wid * 16896);
    const int gw = bid * 8 + wid, NGW = G * 8;
    constexpr int I0 = 32 * 20, I1 = 8 * 48, I2 = 8 * 64, I3 = 32 * 32, I4 = 32 * 97, I5 = 32 * 32, I6 = 32 * 176, I8 = 88 * 32;
    constexpr int NIT = I0 + I1 + I2 + I3 + I4 + I5 + 2 * I6 + 2 * I8;
    for (int it = gw; it < NIT; it += NGW) {
        int r = it;
        if (r < I6) { transpose_item(a.in[11], 2048, 11264, 11264, (bf16_t*)(ws + WS_WGU0), scr, r, lane, 2); continue; } r -= I6;
        if (r < I6) { transpose_item(a.in[11] + (size_t)2048 * 11264, 2048, 11264, 11264, (bf16_t*)(ws + WS_WGU1), scr, r, lane, 2); continue; } r -= I6;
        if (r < I8) { transpose_item(a.in[12], 5632, 2048, 2048, (bf16_t*)(ws + WS_WDN0), scr, r, lane, 0); continue; } r -= I8;
        if (r < I8) { transpose_item(a.in[12] + (size_t)5632 * 2048, 5632, 2048, 2048, (bf16_t*)(ws + WS_WDN1), scr, r, lane, 0); continue; } r -= I8;
        if (r < I4) { transpose_item(a.in[8], 2048, 6160, 6208, (bf16_t*)(ws + WS_WIN1), scr, r, lane, 0); continue; } r -= I4;
        if (r < I0) { transpose_item(a.in[2], 2048, 1088, 1280, (bf16_t*)(ws + WS_WIN0), scr, r, lane, 0); continue; } r -= I0;
        if (r < I1) { transpose_item(a.in[4], 512, 3072, 3072, (bf16_t*)(ws + WS_WQUP), scr, r, lane, 1); continue; } r -= I1;
        if (r < I2) { transpose_item(a.in[6], 512, 4096, 4096, (bf16_t*)(ws + WS_WKVUP), scr, r, lane, 0); continue; } r -= I2;
        if (r < I3) { transpose_item(a.in[7], 2048, 2048, 2048, (bf16_t*)(ws + WS_WO0), scr, r, lane, 0); continue; } r -= I3;
        transpose_item(a.in[10], 2048, 2048, 2048, (bf16_t*)(ws + WS_WO1), scr, r, lane, 0);
    }
    { const f32x4* x4 = (const f32x4*)a.in[0]; u32x4* o = (u32x4*)(ws + WS_XB); const size_t n8 = (size_t)M * DM / 8;
      const size_t stride = (size_t)G * 512;
      for (size_t i = (size_t)bid * 512 + tid; i < n8; i += 4 * stride) { f32x4 v0[4], v1[4];
#pragma unroll
          for (int u = 0; u < 4; ++u) { const size_t j = i + u * stride; if (j < n8) { v0[u] = x4[2 * j]; v1[u] = x4[2 * j + 1]; } }
#pragma unroll
          for (int u = 0; u < 4; ++u) { const size_t j = i + u * stride; if (j < n8) { u32x4 w; w.x = cvtpk2(v0[u][0], v0[u][1]); w.y = cvtpk2(v0[u][2], v0[u][3]); w.z = cvtpk2(v1[u][0], v1[u][1]); w.w = cvtpk2(v1[u][2], v1[u][3]); o[j] = w; } } } }
    { float* tab = (float*)(ws + WS_TAB);
      for (int i = bid * 512 + tid; i < M * 32; i += G * 512) { const int row = i >> 5, j = i & 31;
          const float ang = (float)a.pos[row] * INV_FREQ[j]; const double ad = (double)ang;
          const double kq = __builtin_rint(ad * 0.15915494309189535); const float rf = (float)__builtin_fma(-kq, 6.283185307179586, ad);
          tab[2 * (size_t)i] = cosf(rf); tab[2 * (size_t)i + 1] = sinf(rf); } }
}
__device__ __forceinline__ void phase_ln(float* XR, bf16_t* xb, const float* __restrict__ g, const float* __restrict__ bta, int bid, int G, int wid, int lane) {
    const int gw = bid * 8 + wid, NGW = G * 8;
    for (int row = gw; row < M; row += NGW) {
        f32x4* xr = (f32x4*)(XR + (size_t)row * DM) + lane; f32x4 v[8]; float s = 0.f;
#pragma unroll
        for (int j = 0; j < 8; ++j) { v[j] = xr[64 * j]; s += (v[j][0] + v[j][1]) + (v[j][2] + v[j][3]); }
        const float mean = wave_sum(s) * (1.f / DM); float s2 = 0.f;
#pragma unroll
        for (int j = 0; j < 8; ++j) { v[j] = v[j] - mean; s2 += (v[j][0] * v[j][0] + v[j][1] * v[j][1]) + (v[j][2] * v[j][2] + v[j][3] * v[j][3]); }
        const float rstd = 1.0f / sqrtf(wave_sum(s2) * (1.f / DM) + 1e-5f);
        u32x2* ob = (u32x2*)(xb + (size_t)row * DM) + lane;
#pragma unroll
        for (int j = 0; j < 8; ++j) { const f32x4 gg = ((const f32x4*)g)[lane + 64 * j], bb = ((const f32x4*)bta)[lane + 64 * j]; const f32x4 y = v[j] * rstd * gg + bb;
            xr[64 * j] = y; u32x2 w; w.x = cvtpk2(y[0], y[1]); w.y = cvtpk2(y[2], y[3]); ob[64 * j] = w; }
    }
}
__device__ __forceinline__ void phase_mla_norm(const float* __restrict__ h0, bf16_t* cqn, bf16_t* ckvn, bf16_t* krope, const float* __restrict__ gq, const float* __restrict__ gkv, const float* __restrict__ tab,
                                               int bid, int G, int wid, int lane) {
    const int gw = bid * 8 + wid, NGW = G * 8;
    for (int row = gw; row < M; row += NGW) {
        const float* hr = h0 + (size_t)row * 1280;
#pragma unroll
        for (int part = 0; part < 2; ++part) {
            const f32x4 a0 = *(const f32x4*)(hr + part * 512 + lane * 8), a1 = *(const f32x4*)(hr + part * 512 + lane * 8 + 4);
            float ss = (a0[0] * a0[0] + a0[1] * a0[1]) + (a0[2] * a0[2] + a0[3] * a0[3]) + (a1[0] * a1[0] + a1[1] * a1[1]) + (a1[2] * a1[2] + a1[3] * a1[3]);
            const float rstd = 1.0f / sqrtf(wave_sum(ss) * (1.f / 512.f) + 1e-6f);
            const float* gp = (part ? gkv : gq) + lane * 8; const f32x4 g0 = *(const f32x4*)gp, g1 = *(const f32x4*)(gp + 4);
            const f32x4 y0 = a0 * rstd * g0, y1 = a1 * rstd * g1;
            u32x4 w; w.x = cvtpk2(y0[0], y0[1]); w.y = cvtpk2(y0[2], y0[3]); w.z = cvtpk2(y1[0], y1[1]); w.w = cvtpk2(y1[2], y1[3]);
            *(u32x4*)((part ? ckvn : cqn) + (size_t)row * 512 + lane * 8) = w;
        }
        if (lane < 32) { const float t1 = hr[1024 + lane], t2 = hr[1024 + 32 + lane]; const float c = tab[((size_t)row * 32 + lane) * 2], s = tab[((size_t)row * 32 + lane) * 2 + 1];
            *(unsigned*)(krope + (size_t)row * 64 + 2 * lane) = cvtpk2(t1 * c - t2 * s, t2 * c + t1 * s); }
    }
}

__global__ void __launch_bounds__(512) mega_fwd(Args a) {
    extern __shared__ __attribute__((aligned(16))) unsigned char lds[];
    cg::grid_group grid = cg::this_grid();
    const int wid = __builtin_amdgcn_readfirstlane(threadIdx.x >> 6), G = gridDim.x, bid = blockIdx.x;
#define LANE_TID const int lane = lane_opaque(), tid = wid * 64 + lane; (void)tid
    unsigned char* ws = a.ws; LAS unsigned char* ldsl = (LAS unsigned char*)lds;
    const int lo = a.ph_lo, hi = a.ph_hi;
    float* XR = a.out; bf16_t* xb = (bf16_t*)(ws + WS_XB);
#ifndef PHMASK
#define PHMASK 0x1ffff
#endif
#define IN(k) (((PHMASK >> (k)) & 1) && lo <= (k) && (k) < hi)
    volatile LAS unsigned* bst = (volatile LAS unsigned*)(ldsl + LDS_BYTES - 64);
    { LANE_TID; if (tid < 2) bst[tid] = 0u; }
    __syncthreads();
    XcdBarrier bar; bar.bar = (unsigned*)ws; bar.x = 0; bar.st = bst;
#define SEAM(k) do { if ((k) + 1 < hi) { const bool t0_ = (wid == 0) && (lane_opaque() == 0); if ((k) == 0) { grid.sync(); bar = xcd_barrier_post((unsigned*)ws, bst, t0_); } else xcd_barrier(bar, t0_); } } while (0)
#ifndef REP_PH
#define REP_PH -1
#define REP_N 0
#endif
#define REPS(k) for (int rep_ = 0; rep_ < ((k) == REP_PH ? 1 + REP_N : 1); ++rep_)
#define GEMM(EpiT, E, Ap, Bp, N_, K_) do { pg8::Gemm g_{(const bf16_t*)(Ap), (const bf16_t*)(Bp), M, (N_), (K_)}; pg8::StaticOrder S_; S_.init(M, (N_), G, bid); \
        pg8::gemm_phase<EpiT, pg8::StaticOrder, GALIGN, GSP2>(ldsl, g_, S_, E, wid); } while (0)
    const bool fusedLN = (G == 256) && lo == 0 && hi == NPH;
#ifndef XSKIP
#define XSKIP -1
#endif
#ifndef XSKIPV
#define XSKIPV 0.f
#endif
#define GEMM_LN(ph_, basep, Ap, Bp, K_, gp, bp) do { _Pragma("unroll 1") for (int r_ = 0; r_ < 2; ++r_) { pg8::Gemm g_{(const bf16_t*)(Ap), (const bf16_t*)(Bp), M, 2048, (K_)}; pg8::PanelRound S_{r_, bid}; \
        pg8::EpiResidLN E_{(basep), XR, (ph_) == 15 ? (bf16_t*)nullptr : xb, (gp), (bp), (float*)(ws + WS_PART), bar, ALPHA, (ph_) == XSKIP ? XSKIPV : 1.f}; pg8::gemm_phase<pg8::EpiResidLN, pg8::PanelRound, false, GSP2>(ldsl, g_, S_, E_, wid); __syncthreads(); } } while (0)
    if (IN(0)) { LANE_TID; if (bid == 0) { for (int i = tid; i < XCD_BAR_WORDS; i += 512) __hip_atomic_store((unsigned*)ws + i, 0u, __ATOMIC_RELAXED, __HIP_MEMORY_SCOPE_AGENT); }
#ifdef XPREP2
                 for (int q_ = 0; q_ < XPREP2; ++q_) { phase_prep(a, ws, ldsl, bid, G, tid, wid, lane); __syncthreads(); }
#endif
                 phase_prep(a, ws, ldsl, bid, G, tid, wid, lane); SEAM(0); }
    if (IN(1)) REPS(1) {
        if (fusedLN) {
            { const int lane = lane_opaque(), fr = lane & 15, fq = lane >> 4, hf = wid & 1; const float* tab = (const float*)(ws + WS_TAB); bf16_t* krope = (bf16_t*)(ws + WS_KROPE);
              for (int rg = bid * 4 + (wid >> 1); rg < M / 16; rg += G * 4) { f32x4 acc[2];
                  pg8::skinny_gemm<2>(xb, (const bf16_t*)(ws + WS_WIN0), 1024 + 16 * hf, 32, rg, lane, 0, 2048, acc);
                  const int row = rg * 16 + fr, j0 = 16 * hf + 4 * fq;
                  const f32x4 cs0 = *(const f32x4*)(tab + ((size_t)row * 32 + j0) * 2), cs1 = *(const f32x4*)(tab + ((size_t)row * 32 + j0 + 2) * 2);
                  const f32x4 t1 = acc[0], t2 = acc[1]; u32x4 w;
                  w.x = cvtpk2(t1[0] * cs0[0] - t2[0] * cs0[1], t2[0] * cs0[0] + t1[0] * cs0[1]); w.y = cvtpk2(t1[1] * cs0[2] - t2[1] * cs0[3], t2[1] * cs0[2] + t1[1] * cs0[3]);
                  w.z = cvtpk2(t1[2] * cs1[0] - t2[2] * cs1[1], t2[2] * cs1[0] + t1[2] * cs1[1]); w.w = cvtpk2(t1[3] * cs1[2] - t2[3] * cs1[3], t2[3] * cs1[2] + t1[3] * cs1[3]);
                  *(u32x4*)(krope + (size_t)row * 64 + 2 * j0) = w; } }
            pg8::Gemm g_{xb, (const bf16_t*)(ws + WS_WIN0), M, 1024, 2048}; pg8::QuadOrder S_{bid};
            pg8::EpiRms E_{(bf16_t*)(ws + WS_CQN), (bf16_t*)(ws + WS_CKVN), a.in[3], a.in[5], (float*)(ws + WS_PART), bar};
            pg8::gemm_phase<pg8::EpiRms, pg8::QuadOrder, false, GSP2>(ldsl, g_, S_, E_, wid);
        } else { pg8::EpiF32 E{(float*)(ws + WS_H0), 1280}; GEMM(pg8::EpiF32, E, xb, ws + WS_WIN0, 1280, 2048); }
        SEAM(1); }
    if (IN(2) && !fusedLN) REPS(2) { LANE_TID; phase_mla_norm((const float*)(ws + WS_H0), (bf16_t*)(ws + WS_CQN), (bf16_t*)(ws + WS_CKVN), (bf16_t*)(ws + WS_KROPE), a.in[3], a.in[5], (const float*)(ws + WS_TAB), bid, G, wid, lane); SEAM(2);
#ifdef XSYNC
        for (int q_ = 0; q_ < XSYNC; ++q_) xcd_barrier(bar, (wid == 0) && (lane_opaque() == 0));
#endif
    }
    if (IN(3)) REPS(3) { { pg8::EpiQrope E{(bf16_t*)(ws + WS_Q), (const float*)(ws + WS_TAB)}; GEMM(pg8::EpiQrope, E, ws + WS_CQN, ws + WS_WQUP, 3072, 512); }
                 __syncthreads();
                 { pg8::EpiKV E{(bf16_t*)(ws + WS_K), (bf16_t*)(ws + WS_V)}; GEMM(pg8::EpiKV, E, ws + WS_CKVN, ws + WS_WKVUP, 4096, 512); } SEAM(3); }
    if (IN(4)) REPS(4) { att::attn_phase<192, false>((char*)lds, ldsl, (const att::bf16*)(ws + WS_Q), (const att::bf16*)(ws + WS_K), (const att::bf16*)(ws + WS_KROPE), (const att::bf16*)(ws + WS_V), (att::bf16*)(ws + WS_O), nullptr, G, bid, wid); SEAM(4); }
    if (IN(5)) REPS(5) { if (fusedLN) GEMM_LN(5, a.in[0], ws + WS_O, ws + WS_WO0, 2048, a.in[13], a.in[14]); else { pg8::EpiResid E{a.in[0], XR, DM, ALPHA}; GEMM(pg8::EpiResid, E, ws + WS_O, ws + WS_WO0, 2048, 2048); } SEAM(5); }
    if (IN(6) && !fusedLN) REPS(6) { LANE_TID; phase_ln(XR, xb, a.in[13], a.in[14], bid, G, wid, lane); SEAM(6); }
    if (IN(7)) REPS(7) { pg8::EpiSwiglu E{(bf16_t*)(ws + WS_HFF), FFH}; GEMM(pg8::EpiSwiglu, E, xb, ws + WS_WGU0, 11264, 2048); SEAM(7); }
    if (IN(8)) REPS(8) { if (fusedLN) GEMM_LN(8, XR, ws + WS_HFF, ws + WS_WDN0, 5632, a.in[15], a.in[16]); else { pg8::EpiResid E{XR, XR, DM, ALPHA}; GEMM(pg8::EpiResid, E, ws + WS_HFF, ws + WS_WDN0, 2048, 5632); } SEAM(8); }
    if (IN(9) && !fusedLN) REPS(9) { LANE_TID; phase_ln(XR, xb, a.in[15], a.in[16], bid, G, wid, lane); SEAM(9); }
    if (IN(10)) REPS(10) { { pg8::EpiFoxIn E{(bf16_t*)(ws + WS_FQ), (size_t)(WS_FK - WS_FQ) / 2, (float*)(ws + WS_LOGF), a.in[9]}; GEMM(pg8::EpiFoxIn, E, xb, ws + WS_WIN1, 6144, 2048); }
        { const int lane = lane_opaque(), fr = lane & 15, fq = lane >> 4, hf = wid & 1; LAS f32x4* xch = (LAS f32x4*)ldsl; float* lf = (float*)(ws + WS_LOGF); const f32x4 bb = *(const f32x4*)(a.in[9] + 4 * fq);
          for (int rg = bid * 4 + (wid >> 1); rg < M / 16; rg += G * 4) { f32x4 acc[1];
              pg8::skinny_gemm<1>(xb, (const bf16_t*)(ws + WS_WIN1), 6144, 0, rg, lane, hf * 1024, hf * 1024 + 1024, acc);
              __syncthreads();
              if (hf) xch[(wid >> 1) * 64 + lane] = acc[0];
              __syncthreads();
              if (!hf) { const f32x4 x = acc[0] + xch[(wid >> 1) * 64 + lane] + bb; f32x4 o; o[0] = pg8::lsig(x[0]); o[1] = pg8::lsig(x[1]); o[2] = pg8::lsig(x[2]); o[3] = pg8::lsig(x[3]);
                  *(f32x4*)(lf + (size_t)(rg * 16 + fr) * 16 + 4 * fq) = o; } } }
        SEAM(10); }
    if (IN(11)) REPS(11) { att::attn_phase<128, true>((char*)lds, ldsl, (const att::bf16*)(ws + WS_FQ), (const att::bf16*)(ws + WS_FK), nullptr, (const att::bf16*)(ws + WS_FV), (att::bf16*)(ws + WS_O), (const float*)(ws + WS_LOGF), G, bid, wid); SEAM(11); }
    if (IN(12)) REPS(12) { if (fusedLN) GEMM_LN(12, XR, ws + WS_O, ws + WS_WO1, 2048, a.in[13] + DM, a.in[14] + DM); else { pg8::EpiResid E{XR, XR, DM, ALPHA}; GEMM(pg8::EpiResid, E, ws + WS_O, ws + WS_WO1, 2048, 2048); } SEAM(12); }
    if (IN(13) && !fusedLN) REPS(13) { LANE_TID; phase_ln(XR, xb, a.in[13] + DM, a.in[14] + DM, bid, G, wid, lane); SEAM(13); }
    if (IN(14)) REPS(14) { pg8::EpiSwiglu E{(bf16_t*)(ws + WS_HFF), FFH}; GEMM(pg8::EpiSwiglu, E, xb, ws + WS_WGU1, 11264, 2048); SEAM(14); }
    if (IN(15)) REPS(15) { if (fusedLN) GEMM_LN(15, XR, ws + WS_HFF, ws + WS_WDN1, 5632, a.in[15] + DM, a.in[16] + DM); else { pg8::EpiResid E{XR, XR, DM, ALPHA}; GEMM(pg8::EpiResid, E, ws + WS_HFF, ws + WS_WDN1, 2048, 5632); SEAM(15); } }
    if (IN(16) && !fusedLN) REPS(16) { LANE_TID; phase_ln(XR, xb, a.in[15] + DM, a.in[16] + DM, bid, G, wid, lane); }
#undef IN
#undef SEAM
#undef GEMM
#undef GEMM_LN
}

extern "C" void kernel_launch(void* const* d_in, const int* in_sizes, int n_in, void* d_out, int out_size, void* d_ws, size_t ws_size, hipStream_t stream) {
    static int grid = 0;
    if (grid == 0) {
        int dev = 0, cus = 0, per_cu = 0;
        (void)hipGetDevice(&dev); (void)hipDeviceGetAttribute(&cus, hipDeviceAttributeMultiprocessorCount, dev);
        if (hipFuncSetAttribute((const void*)mega_fwd, hipFuncAttributeMaxDynamicSharedMemorySize, LDS_BYTES) != hipSuccess) fprintf(stderr, "kernel_launch: hipFuncSetAttribute failed\n");
        if (hipOccupancyMaxActiveBlocksPerMultiprocessor(&per_cu, (const void*)mega_fwd, 512, LDS_BYTES) != hipSuccess || per_cu < 1) { fprintf(stderr, "kernel_launch: occupancy query says %d\n", per_cu); per_cu = 1; }
        (void)hipGetLastError();
        if (cus <= 0) cus = 256;
        grid = cus * per_cu;
        if (n_in != 17 || ws_size < 600 * MiB) fprintf(stderr, "kernel_launch: unexpected n_in %d / ws %zu\n", n_in, ws_size);
    }
    Args a{};
    for (int i = 0; i < 17; ++i) a.in[i] = (const float*)d_in[i];
    a.pos = (const int*)d_in[1]; a.out = (float*)d_out; a.ws = (unsigned char*)d_ws;
#if ONE_LAUNCH
    a.ph_lo = 0; a.ph_hi = NPH; { void* args[] = {&a}; hipError_t e = hipLaunchCooperativeKernel((const void*)mega_fwd, dim3(grid), dim3(512), args, LDS_BYTES, stream);
      if (e != hipSuccess) fprintf(stderr, "cooperative launch failed: %s (grid %d)\n", hipGetErrorString(e), grid); }
#else
    for (int k = 0; k < NPH; ++k) { a.ph_lo = k; a.ph_hi = k + 1; void* args[] = {&a}; hipError_t e = hipLaunchCooperativeKernel((const void*)mega_fwd, dim3(grid), dim3(512), args, LDS_BYTES, stream);
      if (e != hipSuccess) { fprintf(stderr, "cooperative launch %d failed: %s (grid %d)\n", k, hipGetErrorString(e), grid); break; } }
#endif
}
```
